# Optimizing an MI355X kernel written in HIP

```python
import math
import jax, jax.numpy as jnp
from jax import lax
import numpy as np

D_MODEL = 2048
BATCH = 4
SEQ = 4096
DEPTH = 1

CHUNK = 64
N_RET_HEADS = 8
RET_HEAD_DIM = D_MODEL // N_RET_HEADS
RET_V_HEAD_DIM = D_MODEL // N_RET_HEADS
D_RET = N_RET_HEADS * RET_HEAD_DIM
D_RET_V = N_RET_HEADS * RET_V_HEAD_DIM
POOL_WINDOWS = (2, 4, 8, 16)
POOL_GROUPS = len(POOL_WINDOWS)
D_POOL = D_MODEL // 2
POOL_GROUP_DIM = D_POOL // POOL_GROUPS
N_BRANCHES = 2
D_FF = ((8 * D_MODEL // 3 + 255) // 256) * 256
ROPE_BASE = 10000.0
NORM_EPS = 1e-6
PROJ_SIZES = (D_RET, D_RET, D_RET_V, D_RET_V, D_POOL, N_BRANCHES * D_MODEL)
D_PROJ = sum(PROJ_SIZES)

kernel_name = "hybrid_retention_pool_block"


def rms_norm(x, g):
    xf = x.astype(jnp.float32)
    y = xf * lax.rsqrt(jnp.mean(xf * xf, axis=-1, keepdims=True) + NORM_EPS)
    if g is not None:
        y = y * g.astype(jnp.float32)
    return y.astype(x.dtype)


def rotary(t, pos):
    dh = t.shape[-1]
    inv_freq = 1.0 / (ROPE_BASE ** (jnp.arange(0, dh, 2, dtype=jnp.float32) / dh))
    ang = pos.astype(jnp.float32)[:, None] * inv_freq[None, :]
    cos = jnp.cos(ang)[None, :, None, :]
    sin = jnp.sin(ang)[None, :, None, :]
    tf = t.astype(jnp.float32)
    t1, t2 = tf[..., : dh // 2], tf[..., dh // 2:]
    out = jnp.concatenate([t1 * cos - t2 * sin, t1 * sin + t2 * cos], axis=-1)
    return out.astype(t.dtype)


def retention_decays(dtype):
    log_g = jnp.log(1.0 - 2.0 ** (-5.0 - jnp.arange(N_RET_HEADS, dtype=jnp.float32)))
    n = jnp.arange(CHUNK, dtype=jnp.float32)
    dist = jnp.abs(n[:, None] - n[None, :])
    d_intra = jnp.exp(log_g[:, None, None] * dist[None])
    q_decay = jnp.exp(log_g[:, None] * (n[None, :] + 1.0))
    k_decay = jnp.exp(log_g[:, None] * (CHUNK - 1.0 - n[None, :]))
    chunk_decay = jnp.exp(log_g * CHUNK)
    return (d_intra.astype(dtype), q_decay.astype(dtype),
            k_decay.astype(dtype), chunk_decay.astype(dtype))


def chunkwise_retention(q, k, v):
    B, S, H, dk = q.shape
    dv = v.shape[-1]
    nc = S // CHUNK

    def to_chunks(t):
        d = t.shape[-1]
        return t.reshape(B, nc, CHUNK, H, d).transpose(1, 0, 3, 2, 4)

    qc, kc, vc = to_chunks(q), to_chunks(k), to_chunks(v)
    d_intra, q_decay, k_decay, chunk_decay = retention_decays(q.dtype)

    def step(state, xs):
        q_i, k_i, v_i = xs
        scores = jnp.einsum('bhnd,bhmd->bhnm', q_i, k_i) * d_intra[None]
        o_intra = jnp.einsum('bhnm,bhmv->bhnv', scores, v_i)
        o_cross = jnp.einsum('bhnd,bhdv->bhnv', q_i * q_decay[None, :, :, None], state)
        new_state = state * chunk_decay[None, :, None, None] + jnp.einsum(
            'bhmd,bhmv->bhdv', k_i * k_decay[None, :, :, None], v_i)
        return new_state, o_intra + o_cross

    state0 = jnp.zeros((B, H, dk, dv), dtype=q.dtype)
    _, o = lax.scan(step, state0, (qc, kc, vc))
    return o.transpose(1, 0, 3, 2, 4).reshape(B, S, H, dv)


def multiscale_causal_pool(p):
    B, S, G, Cg = p.shape
    pf = p.astype(jnp.float32)
    cs = jnp.concatenate([jnp.zeros((B, 1, G, Cg), jnp.float32),
                          jnp.cumsum(pf, axis=1)], axis=1)
    t = jnp.arange(S)
    outs = []
    for g, w in enumerate(POOL_WINDOWS):
        lo = jnp.maximum(t + 1 - w, 0)
        cnt = (t + 1 - lo).astype(jnp.float32)
        win_sum = cs[:, t + 1, g, :] - cs[:, lo, g, :]
        outs.append(win_sum / cnt[None, :, None])
    pooled = jnp.stack(outs, axis=2) - pf
    return pooled.astype(p.dtype)


def setup_inputs(seed: int = 0) -> dict:
    key = jax.random.key(seed)
    ks = jax.random.split(key, 13)
    f32 = jnp.float32

    def dense(k, shape, fan_in):
        return jax.random.normal(k, shape, f32) * (fan_in ** -0.5)

    def gain(k, shape):
        return 1.0 + 0.02 * jax.random.normal(k, shape, f32)

    return {
        "x": jax.random.normal(ks[0], (BATCH, SEQ, D_MODEL), f32),
        "norm1_g": gain(ks[1], (DEPTH, D_MODEL)),
        "w_in": dense(ks[2], (DEPTH, D_MODEL, D_PROJ), D_MODEL),
        "w_ret_branch": dense(ks[3], (DEPTH, D_RET_V, D_MODEL), D_RET_V),
        "w_pool_group": dense(ks[4], (DEPTH, POOL_GROUPS, POOL_GROUP_DIM, POOL_GROUP_DIM), POOL_GROUP_DIM),
        "pool_scale": gain(ks[5], (DEPTH, D_POOL)),
        "w_pool_branch": dense(ks[6], (DEPTH, D_POOL, D_MODEL), D_POOL),
        "w_out": dense(ks[7], (DEPTH, D_MODEL, D_MODEL), D_MODEL),
        "norm2_g": gain(ks[8], (DEPTH, D_MODEL)),
        "w_ffn_in": dense(ks[9], (DEPTH, D_MODEL, 2 * D_FF), D_MODEL),
        "w_ffn_out": dense(ks[10], (DEPTH, D_FF, D_MODEL), D_FF),
        "norm_final_g": gain(ks[11], (D_MODEL,)),
    }


def reference(x, norm1_g, w_in, w_ret_branch, w_pool_group, pool_scale, w_pool_branch,
              w_out, norm2_g, w_ffn_in, w_ffn_out, norm_final_g):
    B, S, _ = x.shape
    pos = jnp.arange(S)
    split_idx = list(np.cumsum(PROJ_SIZES)[:-1])
    scale = RET_HEAD_DIM ** -0.5
    h = x
    for l in range(DEPTH):
        u = rms_norm(h, norm1_g[l])
        proj = u @ w_in[l]
        q, k, v, rg, pz, gates = jnp.split(proj, split_idx, axis=-1)

        q = rotary(q.reshape(B, S, N_RET_HEADS, RET_HEAD_DIM), pos) * scale
        k = rotary(k.reshape(B, S, N_RET_HEADS, RET_HEAD_DIM), pos) * scale
        v = v.reshape(B, S, N_RET_HEADS, RET_V_HEAD_DIM)
        o = chunkwise_retention(q, k, v)
        o = rms_norm(o, None).reshape(B, S, D_RET_V)
        y_ret = (o * jax.nn.silu(rg)) @ w_ret_branch[l]

        pz = pz.reshape(B, S, POOL_GROUPS, POOL_GROUP_DIM)
        pooled = multiscale_causal_pool(pz)
        pooled = jnp.einsum('bsgc,gcd->bsgd', pooled, w_pool_group[l]).reshape(B, S, D_POOL)
        y_pool = (pooled * pool_scale[l]) @ w_pool_branch[l]

        g_ret, g_pool = jnp.split(gates, 2, axis=-1)
        merged = jax.nn.sigmoid(g_ret) * y_ret + jax.nn.sigmoid(g_pool) * y_pool
        h = h + merged @ w_out[l]

        u2 = rms_norm(h, norm2_g[l])
        a, b = jnp.split(u2 @ w_ffn_in[l], 2, axis=-1)
        h = h + (jax.nn.silu(a) * b) @ w_ffn_out[l]
    return rms_norm(h, norm_final_g)
```

```cpp
#include <hip/hip_runtime.h>
#include <hip/hip_cooperative_groups.h>
#include <cstdio>
#include <cstdint>
namespace cg = cooperative_groups;

namespace pg8 {
#define PG8_LAS __attribute__((address_space(3)))
typedef unsigned short bf16_t;
typedef short bf16x8 __attribute__((ext_vector_type(8)));
typedef float f32x4 __attribute__((ext_vector_type(4)));
typedef unsigned u32x4 __attribute__((ext_vector_type(4)));
constexpr int BM = 256, BK = 64, HALF = 128, HTB = HALF * BK * 2  , STAGE_BYTES = 8 * HTB, NXCD = 8, WGM = 4;

__host__ __device__ __forceinline__ int lds_byte(int r, int c) { const int st = (r >> 4) * 2 + (c >> 5), rr = r & 15, cc = c & 31, ob = rr * 64 + cc * 2; return st * 1024 + (ob ^ (((ob >> 9) & 1) << 5)); }
__host__ __device__ __forceinline__ void stage_rc(int b, int& R, int& C) { const int st = b / 1024, sb = b % 1024, swz = sb ^ (((sb >> 9) & 1) << 5); R = (st >> 1) * 16 + swz / 64; C = (st & 1) * 32 + (swz % 64) / 2; }
__host__ __device__ __forceinline__ int perm32(int rho) { const int n = rho >> 4, i = rho & 15; return 8 * (i >> 2) + 4 * n + (i & 3); }

struct Unit { int pm, pn; };
struct Gemm { const bf16_t* A; const bf16_t* Bt; int lda, ldb, K, a_pn_off; };

struct StaticOrder {
    int nM, nN, nwg, G, c;
    __host__ __device__ void init(int M, int N, int G_, int c_) { nM = M / BM; nN = N / BM; nwg = nM * nN; G = G_; c = c_; }
    __host__ __device__ bool next(int i, Unit& u) const {
        const long L = (long)i * G + c; if (L >= nwg) return false;
        int wgid = (int)L; { const int q = nwg / NXCD, r = nwg % NXCD, xcd = wgid % NXCD, off = wgid / NXCD; wgid = (xcd < r ? xcd * (q + 1) : r * (q + 1) + (xcd - r) * q) + off; }
        const int nig = WGM * nN, gid = wgid / nig, fm = gid * WGM, gsz = (nM - fm) < WGM ? (nM - fm) : WGM;
        u.pm = fm + ((wgid % nig) % gsz); u.pn = (wgid % nig) / gsz; return true;
    }
    __device__ __forceinline__ void a_ready(const Unit&) const {}
    __device__ __forceinline__ void done(const Unit&) const {}
};

typedef __bf16 bf16x2_cv __attribute__((ext_vector_type(2)));
typedef float f32x2_cv __attribute__((ext_vector_type(2)));
__device__ __forceinline__ unsigned cvt_pk_bf16(float lo, float hi) { const f32x2_cv v = {lo, hi}; const bf16x2_cv b = __builtin_convertvector(v, bf16x2_cv); return __builtin_bit_cast(unsigned, b); }

template <class Epi, class Sched, bool ALIGN_EPI = false, bool SP2 = false>
__device__ __forceinline__ void gemm_phase(PG8_LAS unsigned char* lds, const Gemm g, const Sched& S, const Epi& E) {
    int tid_o = threadIdx.x; asm volatile("" : "+v"(tid_o));
    const int tid = tid_o, wid = __builtin_amdgcn_readfirstlane(tid >> 6), lane = tid & 63, wr = wid >> 2, wc = wid & 3, fr = lane & 15, fq = lane >> 4;
    const int K = g.K, nt = K / BK;
    unsigned voffA[2], voffB[2];
#pragma unroll
    for (int i = 0; i < 2; ++i) { int R, C; stage_rc(tid * 16 + i * 8192, R, C); const int Rb = Epi::PERM ? ((R & ~31) + perm32(R & 31)) : R;
        voffA[i] = (unsigned)(R * g.lda + C) * 2u; voffB[i] = (unsigned)(Rb * g.ldb + C) * 2u; }
    const size_t kstep = (size_t)(BK * 2);
    const size_t hA = (size_t)HALF * g.lda * 2, hB = (size_t)HALF * g.ldb * 2;
    const size_t tA = 2 * hA, tB = 2 * hB, pnA = (size_t)g.a_pn_off * 2;
    const unsigned ldsw = (unsigned)wid * 1024u;
    const int aoff = lds_byte(wr * 64 + fr, fq * 8), boff = lds_byte(wc * 32 + fr, fq * 8);
#define PG8_SA(b, h) (((b) * 2 + (h)) * HTB)
#define PG8_SB(b, h) ((4 + (b) * 2 + (h)) * HTB)
#define PG8_STAGE(bufoff, gbase, voff) do { _Pragma("unroll") for (int _i = 0; _i < 2; ++_i) \
        __builtin_amdgcn_global_load_lds((const unsigned*)((const char*)(gbase) + (voff)[_i]), (PG8_LAS unsigned*)(lds + (bufoff) + ldsw + _i * 8192), 16, 0, 0); } while (0)
#define PG8_LDA(dst, b, h) do { _Pragma("unroll") for (int m = 0; m < 4; ++m) _Pragma("unroll") for (int k = 0; k < 2; ++k) dst[m][k] = *(const PG8_LAS bf16x8*)(lds + PG8_SA(b, h) + aoff + m * 2048 + k * 1024); } while (0)
#define PG8_LDB(dst, b, h) do { _Pragma("unroll") for (int n = 0; n < 2; ++n) _Pragma("unroll") for (int k = 0; k < 2; ++k) dst[n][k] = *(const PG8_LAS bf16x8*)(lds + PG8_SB(b, h) + boff + n * 2048 + k * 1024); } while (0)
#define PG8_MMA(ai, bj, At, Bt) do { __builtin_amdgcn_s_setprio(1); _Pragma("unroll") for (int m = 0; m < 4; ++m) _Pragma("unroll") for (int n = 0; n < 2; ++n) _Pragma("unroll") for (int k = 0; k < 2; ++k) \
        acc[ai][bj][m][n] = __builtin_amdgcn_mfma_f32_16x16x32_bf16(Bt[n][k], At[m][k], acc[ai][bj][m][n], 0, 0, 0); __builtin_amdgcn_s_setprio(0); } while (0)
#define PG8_WAIT_V(n) asm volatile("s_waitcnt vmcnt(" #n ")" ::: "memory")
#define PG8_WAIT_L(n) asm volatile("s_waitcnt lgkmcnt(" #n ")" ::: "memory")
#define PG8_BAR __builtin_amdgcn_s_barrier()
#define PG8_SCHED __builtin_amdgcn_sched_barrier(0)
    Unit cur, nxt; int ui = 0;
    if (!S.next(0, cur)) return;
    f32x4 acc[2][2][4][2];
#pragma unroll
    for (int a = 0; a < 2; ++a)
#pragma unroll
        for (int b = 0; b < 2; ++b)
#pragma unroll
            for (int m = 0; m < 4; ++m)
#pragma unroll
                for (int n = 0; n < 2; ++n) acc[a][b][m][n] = (f32x4){0.f, 0.f, 0.f, 0.f};
    bf16x8 At[4][2], B0[2][2], B1[2][2];
    const char* cA = (const char*)g.A + (size_t)cur.pm * tA + (size_t)cur.pn * pnA; const char* cB = (const char*)g.Bt + (size_t)cur.pn * tB;
    S.a_ready(cur);
    if constexpr (SP2) {
        PG8_STAGE(PG8_SB(0, 0), cB, voffB); PG8_STAGE(PG8_SB(0, 1), cB + hB, voffB); PG8_STAGE(PG8_SA(0, 0), cA, voffA); PG8_STAGE(PG8_SA(0, 1), cA + hA, voffA);
        if (wr == 1) PG8_BAR;
        PG8_WAIT_V(2); PG8_BAR;
        PG8_STAGE(PG8_SB(1, 0), cB + kstep, voffB); PG8_STAGE(PG8_SA(1, 0), cA + kstep, voffA); PG8_STAGE(PG8_SB(1, 1), cB + hB + kstep, voffB);
        PG8_WAIT_V(6); PG8_BAR;
    } else {
        PG8_STAGE(PG8_SB(0, 0), cB, voffB); PG8_STAGE(PG8_SA(0, 0), cA, voffA); PG8_STAGE(PG8_SB(0, 1), cB + hB, voffB); PG8_STAGE(PG8_SA(0, 1), cA + hA, voffA);
        if (wr == 1) PG8_BAR;
        PG8_WAIT_V(4); PG8_BAR;
        PG8_STAGE(PG8_SB(1, 0), cB + kstep, voffB); PG8_STAGE(PG8_SA(1, 0), cA + kstep, voffA); PG8_STAGE(PG8_SB(1, 1), cB + hB + kstep, voffB);
        PG8_WAIT_V(6); PG8_BAR;
    }
    for (;;) {
        const bool has_next = S.next(ui + 1, nxt);
        const char* nA = has_next ? (const char*)g.A + (size_t)nxt.pm * tA + (size_t)nxt.pn * pnA : cA; const char* nB = has_next ? (const char*)g.Bt + (size_t)nxt.pn * tB : cB;
#pragma nounroll
        for (int t = 0; t < nt; t += 2) {
            const bool last = (t == nt - 2);
            const char* a1 = cA + (size_t)(t + 1) * kstep;
            const char* a2 = last ? nA : cA + (size_t)(t + 2) * kstep; const char* b2 = last ? nB : cB + (size_t)(t + 2) * kstep;
            const char* a3 = a2 + kstep; const char* b3 = b2 + kstep;
            if (last && has_next) S.a_ready(nxt);
            if constexpr (SP2) {
            PG8_LDB(B0, 0, 0); PG8_LDB(B1, 0, 1); PG8_SCHED; PG8_LDA(At, 0, 0); PG8_STAGE(PG8_SA(1, 1), a1 + hA, voffA);
            PG8_WAIT_V(8); PG8_WAIT_L(0); PG8_BAR; PG8_MMA(0, 0, At, B0); PG8_MMA(0, 1, At, B1); PG8_BAR; PG8_SCHED;
            PG8_LDA(At, 0, 1); PG8_STAGE(PG8_SB(0, 0), b2, voffB); PG8_STAGE(PG8_SB(0, 1), b2 + hB, voffB); PG8_STAGE(PG8_SA(0, 0), a2, voffA);
            PG8_WAIT_V(8); PG8_WAIT_L(0); PG8_BAR; PG8_MMA(1, 0, At, B0); PG8_MMA(1, 1, At, B1); PG8_BAR; PG8_SCHED;
            PG8_LDB(B0, 1, 0); PG8_LDB(B1, 1, 1); PG8_SCHED; PG8_LDA(At, 1, 0); PG8_STAGE(PG8_SA(0, 1), a2 + hA, voffA);
            PG8_WAIT_V(8); PG8_WAIT_L(0); PG8_BAR; PG8_MMA(0, 0, At, B0); PG8_MMA(0, 1, At, B1); PG8_BAR; PG8_SCHED;
            PG8_LDA(At, 1, 1); PG8_STAGE(PG8_SB(1, 0), b3, voffB); PG8_STAGE(PG8_SB(1, 1), b3 + hB, voffB); PG8_STAGE(PG8_SA(1, 0), a3, voffA);
            PG8_WAIT_V(8); PG8_WAIT_L(0); PG8_BAR; PG8_MMA(1, 0, At, B0); PG8_MMA(1, 1, At, B1); PG8_BAR; PG8_SCHED;
            } else {
            PG8_LDB(B0, 0, 0); PG8_SCHED; PG8_LDA(At, 0, 0); PG8_STAGE(PG8_SA(1, 1), a1 + hA, voffA);
            PG8_WAIT_L(8); PG8_BAR; PG8_WAIT_L(0); PG8_MMA(0, 0, At, B0); PG8_BAR; PG8_SCHED;
            PG8_LDB(B1, 0, 1); PG8_STAGE(PG8_SB(0, 0), b2, voffB);
            PG8_BAR; PG8_WAIT_L(0); PG8_MMA(0, 1, At, B1); PG8_BAR;
            PG8_LDA(At, 0, 1); PG8_STAGE(PG8_SA(0, 0), a2, voffA);
            PG8_BAR; PG8_WAIT_L(0); PG8_MMA(1, 0, At, B0); PG8_BAR; PG8_SCHED;
            PG8_STAGE(PG8_SB(0, 1), b2 + hB, voffB);
            PG8_WAIT_V(6); PG8_BAR; PG8_MMA(1, 1, At, B1); PG8_BAR;
            PG8_LDB(B0, 1, 0); PG8_SCHED; PG8_LDA(At, 1, 0); PG8_STAGE(PG8_SA(0, 1), a2 + hA, voffA);
            PG8_WAIT_L(8); PG8_BAR; PG8_WAIT_L(0); PG8_MMA(0, 0, At, B0); PG8_BAR; PG8_SCHED;
            PG8_LDB(B1, 1, 1); PG8_STAGE(PG8_SB(1, 0), b3, voffB);
            PG8_BAR; PG8_WAIT_L(0); PG8_MMA(0, 1, At, B1); PG8_BAR;
            PG8_LDA(At, 1, 1); PG8_STAGE(PG8_SA(1, 0), a3, voffA);
            PG8_BAR; PG8_WAIT_L(0); PG8_MMA(1, 0, At, B0); PG8_BAR; PG8_SCHED;
            PG8_STAGE(PG8_SB(1, 1), b3 + hB, voffB);
            PG8_WAIT_V(6); PG8_BAR; PG8_MMA(1, 1, At, B1); PG8_BAR;
            }
        }
        if constexpr (ALIGN_EPI) { if (wr == 0) PG8_BAR; }
        if constexpr (!Epi::AFTER_DRAIN) { E(acc, cur, wr, wc, fr, fq); S.done(cur); }
        if (!has_next) break;
#pragma unroll
        for (int a = 0; a < 2; ++a)
#pragma unroll
            for (int b = 0; b < 2; ++b)
#pragma unroll
                for (int m = 0; m < 4; ++m)
#pragma unroll
                    for (int n = 0; n < 2; ++n) acc[a][b][m][n] = (f32x4){0.f, 0.f, 0.f, 0.f};
        cur = nxt; cA = nA; cB = nB; ++ui;
        if constexpr (ALIGN_EPI) { if (wr == 1) PG8_BAR; }
    }
    PG8_WAIT_V(0);
    if constexpr (!ALIGN_EPI) { if (wr == 0) PG8_BAR; }
    PG8_BAR;
    if constexpr (Epi::AFTER_DRAIN) { E.fused(acc, cur, wr, wc, fr, fq, lds, wid, lane); S.done(cur); }
#undef PG8_SA
#undef PG8_SB
#undef PG8_STAGE
#undef PG8_LDA
#undef PG8_LDB
#undef PG8_MMA
#undef PG8_WAIT_V
#undef PG8_WAIT_L
#undef PG8_BAR
#undef PG8_SCHED
}
}

using pg8::bf16x8; using pg8::f32x4; using pg8::u32x4; using pg8::cvt_pk_bf16;
typedef unsigned short bf16;
typedef float f32x16 __attribute__((ext_vector_type(16)));
typedef unsigned u32x2 __attribute__((ext_vector_type(2)));
#define LAS __attribute__((address_space(3)))
#define GAS __attribute__((address_space(1)))
#define LDS_WAIT() asm volatile("s_waitcnt lgkmcnt(0)" ::: "memory")

constexpr int M = 16384, D = 2048, SEQ = 4096, NPROJ = 13312, DFF = 5632, DPOOL = 1024;
constexpr float EPS = 1e-6f;
constexpr size_t MiB = 1u << 20;
constexpr size_t WS_TCOS = 1 * MiB, WS_TSIN = 3 * MiB, WS_WPG = 5 * MiB, WS_WRET = 6 * MiB, WS_WPB = 14 * MiB, WS_WOUT = 18 * MiB,
    WS_SS = 26 * MiB, WS_PART = 30 * MiB, WS_PART2 = 32 * MiB,
    WS_WIN = 36 * MiB, WS_WFI = 36 * MiB,
    WS_Q = 88 * MiB, WS_OG = 88 * MiB, WS_ACT = 88 * MiB,
    WS_K = 152 * MiB, WS_O = 152 * MiB, WS_MERGED = 152 * MiB,
    WS_VT = 216 * MiB, WS_TMP = 216 * MiB,
    WS_KDT = 280 * MiB, WS_WFO = 280 * MiB,
    WS_SRG = 344 * MiB, WS_HB = 344 * MiB,
    WS_U = 408 * MiB, WS_PP = 408 * MiB, WS_PIN = 424 * MiB,
    WS_PZ = 472 * MiB, WS_P2 = 472 * MiB,
    WS_END = 504 * MiB;
constexpr int LDS_BYTES = 147456;
#ifndef PHASES
#define PHASES 0x3ff
#endif
#ifndef REPEAT
#define REPEAT 0x0
#endif

__device__ __forceinline__ u32x4 pack8(f32x4 a, f32x4 b) { u32x4 w; w.x = cvt_pk_bf16(a[0], a[1]); w.y = cvt_pk_bf16(a[2], a[3]); w.z = cvt_pk_bf16(b[0], b[1]); w.w = cvt_pk_bf16(b[2], b[3]); return w; }
__device__ __forceinline__ void unpack8(u32x4 w, f32x4& a, f32x4& b) {
    a[0] = __uint_as_float(w.x << 16); a[1] = __uint_as_float(w.x & 0xffff0000u); a[2] = __uint_as_float(w.y << 16); a[3] = __uint_as_float(w.y & 0xffff0000u);
    b[0] = __uint_as_float(w.z << 16); b[1] = __uint_as_float(w.z & 0xffff0000u); b[2] = __uint_as_float(w.w << 16); b[3] = __uint_as_float(w.w & 0xffff0000u); }
__device__ __forceinline__ unsigned short f2bf(float f) { unsigned u = __float_as_uint(f); return (unsigned short)((u + 0x7fffu + ((u >> 16) & 1u)) >> 16); }
__device__ __forceinline__ float sigmoidf_(float x) { return __builtin_amdgcn_rcpf(1.0f + __expf(-x)); }
__device__ __forceinline__ f32x4 sig4(f32x4 v) { f32x4 r; r[0] = sigmoidf_(v[0]); r[1] = sigmoidf_(v[1]); r[2] = sigmoidf_(v[2]); r[3] = sigmoidf_(v[3]); return r; }
__device__ __forceinline__ float dot4(f32x4 a) { return (a[0] * a[0] + a[1] * a[1]) + (a[2] * a[2] + a[3] * a[3]); }
__device__ __forceinline__ float sum4(f32x4 a) { return (a[0] + a[1]) + (a[2] + a[3]); }
__device__ __forceinline__ float wave_sum(float v) {
#pragma unroll
    for (int o = 1; o < 64; o <<= 1) v += __shfl_xor(v, o);
    return v;
}
__device__ __forceinline__ float head_lg2(int h) { return log2f(1.0f - exp2f(-5.0f - (float)h)); }

__device__ __forceinline__ unsigned dpp_xor1(unsigned v) { return (unsigned)__builtin_amdgcn_update_dpp(0, (int)v, 0xB1, 0xF, 0xF, true); }
__device__ __forceinline__ unsigned dpp_xor2(unsigned v) { return (unsigned)__builtin_amdgcn_update_dpp(0, (int)v, 0x4E, 0xF, 0xF, true); }
__device__ __forceinline__ void quad_transpose(unsigned& x0, unsigned& x1, unsigned& x2, unsigned& x3, int b) {
    const bool o1 = (b & 1) != 0, o2 = (b & 2) != 0;
    const unsigned r01 = dpp_xor1(o1 ? x0 : x1), r23 = dpp_xor1(o1 ? x2 : x3);
    if (o1) { x0 = r01; x2 = r23; } else { x1 = r01; x3 = r23; }
    const unsigned r02 = dpp_xor2(o2 ? x0 : x2), r13 = dpp_xor2(o2 ? x1 : x3);
    if (o2) { x0 = r02; x1 = r13; } else { x2 = r02; x3 = r13; }
}
__device__ __forceinline__ void tr_store(bf16* p, int second, f32x4 v0, f32x4 v1, int b) {
    unsigned x0 = cvt_pk_bf16(v0[0], v0[1]), x1 = cvt_pk_bf16(v0[2], v0[3]), x2 = cvt_pk_bf16(v1[0], v1[1]), x3 = cvt_pk_bf16(v1[2], v1[3]);
    quad_transpose(x0, x1, x2, x3, b);
    u32x2 lo, hi; lo.x = __builtin_amdgcn_perm(x1, x0, 0x05040100u); lo.y = __builtin_amdgcn_perm(x3, x2, 0x05040100u);
    hi.x = __builtin_amdgcn_perm(x1, x0, 0x07060302u); hi.y = __builtin_amdgcn_perm(x3, x2, 0x07060302u);
    *(u32x2*)p = lo; *(u32x2*)(p + second) = hi;
}

typedef const f32x4 (&AccRef)[2][2][4][2];

struct EpiProj {
    static constexpr bool PERM = true, AFTER_DRAIN = false;
    bf16 *q, *k, *kdT, *vT, *srg, *pz, *sg; const float *tcos, *tsin;
    __device__ __forceinline__ void operator()(AccRef acc, const pg8::Unit& u, int wr, int wc, int fr, int fq) const {
        const int pn = u.pn, row0 = u.pm * 256 + wr * 64 + fr, cl = wc * 32 + 8 * fq;
        if (pn < 16) {
            const bool isk = pn >= 8; const int h = pn & 7; bf16* dst = isk ? k : q;
            const float lg2 = head_lg2(h);
#pragma unroll
            for (int ai = 0; ai < 2; ++ai) {
                f32x4 tcv[4][2], tsv[4][2];
#pragma unroll
                for (int m = 0; m < 4; ++m) { const int pos_ = (row0 + ai * 128 + m * 16) & 4095; const float* tc = tcos + pos_ * 128 + cl; const float* ts = tsin + pos_ * 128 + cl;
                    tcv[m][0] = *(const f32x4*)tc; tcv[m][1] = *(const f32x4*)(tc + 4); tsv[m][0] = *(const f32x4*)ts; tsv[m][1] = *(const f32x4*)(ts + 4); }
#pragma unroll
                for (int m = 0; m < 4; ++m) {
                    int r = row0 + ai * 128 + m * 16; asm volatile("" : "+v"(r)); const int pos = r & 4095;
                    const f32x4 c0 = tcv[m][0], c1 = tcv[m][1], s0 = tsv[m][0], s1 = tsv[m][1];
                    const f32x4 a0 = acc[ai][0][m][0], a1 = acc[ai][0][m][1], b0 = acc[ai][1][m][0], b1 = acc[ai][1][m][1];
                    const f32x4 o10 = (a0 * c0 - b0 * s0) * 0.0625f, o11 = (a1 * c1 - b1 * s1) * 0.0625f;
                    const f32x4 o20 = (a0 * s0 + b0 * c0) * 0.0625f, o21 = (a1 * s1 + b1 * c1) * 0.0625f;
                    const size_t blk = ((size_t)(((r >> 12) * 8 + h) * 64 + (pos >> 6))) * 16384;
                    const int nn = r & 63;
                    bf16* rp = dst + blk + (size_t)(((((cl >> 5) * 2 + (nn >> 5)) * 2 + ((cl >> 4) & 1)) * 64 + ((cl >> 3) & 1) * 32 + (nn & 31)) * 8);
                    *(u32x4*)rp = pack8(o10, o11); *(u32x4*)(rp + 4 * 2048) = pack8(o20, o21);
                    if (isk) {
                        const float kd = exp2f((float)(63 - (r & 63)) * lg2);
                        const int dq = cl + 2 * (fr & 3), dl = dq & 31, sg2 = (dl & 0x13) | ((dl & 4) << 1) | ((dl & 8) >> 1);
                        bf16* tb = kdT + blk + (size_t)((((dq >> 5) * 4 + m) * 64 + ((fr >> 3) & 1) * 32 + sg2) * 8 + (fr & 4));
                        tr_store(tb, 8, o10 * kd, o11 * kd, fr & 3); tr_store(tb + 4 * 4 * 64 * 8, 8, o20 * kd, o21 * kd, fr & 3);
                    }
                }
                asm volatile("" ::: "memory");
            }
        } else if (pn < 24) {
            const int h = pn - 16;
#pragma unroll
            for (int ai = 0; ai < 2; ++ai)
#pragma unroll
                for (int m = 0; m < 4; ++m) {
                    int r = row0 + ai * 128 + m * 16; asm volatile("" : "+v"(r)); const int pos = r & 4095;
                    const int vq = cl + 2 * (fr & 3);
                    bf16* tb = vT + ((size_t)(((r >> 12) * 8 + h) * 64 + (pos >> 6))) * 16384 + (size_t)((((vq >> 5) * 4 + m) * 64 + ((fr >> 3) & 1) * 32 + (vq & 31)) * 8 + (fr & 4));
                    tr_store(tb, 8, acc[ai][0][m][0], acc[ai][0][m][1], fr & 3); tr_store(tb + 4 * 4 * 64 * 8, 8, acc[ai][1][m][0], acc[ai][1][m][1], fr & 3);
                }
        } else if (pn < 32) {
            const int c0 = (pn - 24) * 256 + cl;
#pragma unroll
            for (int ai = 0; ai < 2; ++ai)
#pragma unroll
                for (int m = 0; m < 4; ++m) { const int r = row0 + ai * 128 + m * 16;
#pragma unroll
                    for (int bj = 0; bj < 2; ++bj) { const f32x4 v0 = acc[ai][bj][m][0], v1 = acc[ai][bj][m][1];
                        *(u32x4*)(srg + (size_t)r * 2048 + c0 + bj * 128) = pack8(v0 * sig4(v0), v1 * sig4(v1)); } }
        } else if (pn < 36) {
            const int c0 = (pn - 32) * 256 + cl;
#pragma unroll
            for (int ai = 0; ai < 2; ++ai)
#pragma unroll
                for (int m = 0; m < 4; ++m) { const int r = row0 + ai * 128 + m * 16;
#pragma unroll
                    for (int bj = 0; bj < 2; ++bj) *(u32x4*)(pz + (size_t)r * 1024 + c0 + bj * 128) = pack8(acc[ai][bj][m][0], acc[ai][bj][m][1]); }
        } else {
            const int c0 = (pn - 36) * 256 + cl;
#pragma unroll
            for (int ai = 0; ai < 2; ++ai)
#pragma unroll
                for (int m = 0; m < 4; ++m) { const int r = row0 + ai * 128 + m * 16;
#pragma unroll
                    for (int bj = 0; bj < 2; ++bj) *(u32x4*)(sg + (size_t)r * 4096 + c0 + bj * 128) = pack8(sig4(acc[ai][bj][m][0]), sig4(acc[ai][bj][m][1])); }
        }
    }
};

struct EpiPlain {
    static constexpr bool PERM = true, AFTER_DRAIN = false;
    bf16* O; int ldc;
    __device__ __forceinline__ void operator()(AccRef acc, const pg8::Unit& u, int wr, int wc, int fr, int fq) const {
        const int row0 = u.pm * 256 + wr * 64 + fr, c0 = u.pn * 256 + wc * 32 + 8 * fq;
#pragma unroll
        for (int ai = 0; ai < 2; ++ai)
#pragma unroll
            for (int m = 0; m < 4; ++m) { const int r = row0 + ai * 128 + m * 16;
#pragma unroll
                for (int bj = 0; bj < 2; ++bj) *(u32x4*)(O + (size_t)r * ldc + c0 + bj * 128) = pack8(acc[ai][bj][m][0], acc[ai][bj][m][1]); }
    }
};

template <bool SECOND> struct EpiGate {
    static constexpr bool PERM = true, AFTER_DRAIN = false;
    const bf16* sg; bf16* tmp; bf16* merged;
    __device__ __forceinline__ void operator()(AccRef acc, const pg8::Unit& u, int wr, int wc, int fr, int fq) const {
        const int row0 = u.pm * 256 + wr * 64 + fr, c0 = u.pn * 256 + wc * 32 + 8 * fq;
#pragma unroll
        for (int ai = 0; ai < 2; ++ai) {
            u32x4 gv[4][2], tv[4][2];
#pragma unroll
            for (int m = 0; m < 4; ++m) { const int r = row0 + ai * 128 + m * 16;
#pragma unroll
                for (int bj = 0; bj < 2; ++bj) { const int c = c0 + bj * 128;
                    gv[m][bj] = *(const u32x4*)(sg + (size_t)r * 4096 + (SECOND ? 0 : 2048) + c);
                    if (SECOND) tv[m][bj] = *(const u32x4*)(tmp + (size_t)r * 2048 + c); } }
#pragma unroll
            for (int m = 0; m < 4; ++m) { const int r = row0 + ai * 128 + m * 16;
#pragma unroll
                for (int bj = 0; bj < 2; ++bj) { const int c = c0 + bj * 128;
                    f32x4 g0, g1; unpack8(gv[m][bj], g0, g1);
                    f32x4 v0 = g0 * acc[ai][bj][m][0], v1 = g1 * acc[ai][bj][m][1];
                    if (SECOND) { f32x4 t0, t1; unpack8(tv[m][bj], t0, t1); v0 += t0; v1 += t1;
                        *(u32x4*)(merged + (size_t)r * 2048 + c) = pack8(v0, v1); }
                    else *(u32x4*)(tmp + (size_t)r * 2048 + c) = pack8(v0, v1); } }
            asm volatile("" ::: "memory"); }
    }
};

template <bool FIRST> struct EpiRes {
    static constexpr bool PERM = true, AFTER_DRAIN = false;
    const float* x; bf16* hb; float* hout; float* part;
    __device__ __forceinline__ void operator()(AccRef acc, const pg8::Unit& u, int wr, int wc, int fr, int fq) const {
        const int row0 = u.pm * 256 + wr * 64 + fr, c0 = u.pn * 256 + wc * 32 + 8 * fq;
#pragma unroll
        for (int ai = 0; ai < 2; ++ai) {
            f32x4 xv[4][2][2]; u32x4 hv[4][2];
#pragma unroll
            for (int m = 0; m < 4; ++m) { const int r = row0 + ai * 128 + m * 16;
#pragma unroll
                for (int bj = 0; bj < 2; ++bj) { const size_t off = (size_t)r * 2048 + c0 + bj * 128;
                    if (FIRST) { xv[m][bj][0] = *(const f32x4*)(x + off); xv[m][bj][1] = *(const f32x4*)(x + off + 4); } else hv[m][bj] = *(const u32x4*)(hb + off); } }
#pragma unroll
            for (int m = 0; m < 4; ++m) { const int r = row0 + ai * 128 + m * 16; float s = 0.f;
#pragma unroll
                for (int bj = 0; bj < 2; ++bj) { const size_t off = (size_t)r * 2048 + c0 + bj * 128;
                    f32x4 h0, h1;
                    if (FIRST) { h0 = xv[m][bj][0] + acc[ai][bj][m][0]; h1 = xv[m][bj][1] + acc[ai][bj][m][1]; }
                    else { unpack8(hv[m][bj], h0, h1); h0 += acc[ai][bj][m][0]; h1 += acc[ai][bj][m][1]; }
                    *(u32x4*)(hb + off) = pack8(h0, h1);
                    s += dot4(h0) + dot4(h1); }
                s += __shfl_xor(s, 16); s += __shfl_xor(s, 32);
                if (fq == 0) part[(size_t)r * 32 + u.pn * 4 + wc] = s; }
            asm volatile("" ::: "memory"); }
    }
};

struct EpiSwiglu {
    static constexpr bool PERM = true, AFTER_DRAIN = false;
    const float* part; bf16* act;
    __device__ __forceinline__ void operator()(AccRef acc, const pg8::Unit& u, int wr, int wc, int fr, int fq) const {
        const int row0 = u.pm * 256 + wr * 64 + fr, c0 = u.pn * 128 + wc * 32 + 8 * fq;
        float r2[2][4];
#pragma unroll
        for (int ai = 0; ai < 2; ++ai)
#pragma unroll
            for (int m = 0; m < 4; ++m) { const int r = row0 + ai * 128 + m * 16;
                const float* pp = part + (size_t)r * 32 + 8 * fq;
                float s = sum4(*(const f32x4*)pp) + sum4(*(const f32x4*)(pp + 4));
                s += __shfl_xor(s, 16); s += __shfl_xor(s, 32);
                r2[ai][m] = 1.0f / sqrtf(s * (1.0f / 2048.0f) + EPS); }
#pragma unroll
        for (int ai = 0; ai < 2; ++ai)
#pragma unroll
            for (int m = 0; m < 4; ++m) { const int r = row0 + ai * 128 + m * 16; const float rr = r2[ai][m];
                const f32x4 a0 = acc[ai][0][m][0] * rr, a1 = acc[ai][0][m][1] * rr, b0 = acc[ai][1][m][0] * rr, b1 = acc[ai][1][m][1] * rr;
                *(u32x4*)(act + (size_t)r * DFF + c0) = pack8(a0 * sig4(a0) * b0, a1 * sig4(a1) * b1); }
    }
};

__device__ __forceinline__ void conv_matrix(const float* W, int K, int N, bf16* WT, const float* sk, const float* sn, int mode, LAS float* scr, int lane, int gw, int NGW) {
    const int nblk = N / 32, nitems = (K / 64) * nblk;
    float v[32];
    int it = gw;
    if (it < nitems) { const int kb = it / nblk, nb = it - kb * nblk; const float* src = W + (size_t)(64 * kb + (lane >> 5)) * N + 32 * nb + (lane & 31);
#pragma unroll
        for (int i = 0; i < 32; ++i) v[i] = src[(size_t)(2 * i) * N]; }
    for (; it < nitems; it += NGW) {
        const int kb = it / nblk, nb = it - kb * nblk, n0 = 32 * nb, k0 = 64 * kb; int drow0 = n0;
        if (mode == 1) drow0 = n0 < DFF ? 256 * (n0 >> 7) + (n0 & 127) : 256 * ((n0 - DFF) >> 7) + 128 + ((n0 - DFF) & 127);
#pragma unroll
        for (int i = 0; i < 32; ++i) { const int kk = 2 * i + (lane >> 5); float t = v[i]; if (sk) t *= sk[k0 + kk]; scr[kk * 33 + (lane & 31)] = t; }
        const int nx = it + NGW;
        if (nx < nitems) { const int kb2 = nx / nblk, nb2 = nx - kb2 * nblk; const float* src = W + (size_t)(64 * kb2 + (lane >> 5)) * N + 32 * nb2 + (lane & 31);
#pragma unroll
            for (int i = 0; i < 32; ++i) v[i] = src[(size_t)(2 * i) * N]; }
        LDS_WAIT(); asm volatile("" ::: "memory");
        const int c = lane & 7;
#pragma unroll
        for (int j = 0; j < 4; ++j) { const int n = (lane >> 3) + 8 * j; const LAS float* sp = scr + (8 * c) * 33 + n; const float mn = sn ? sn[n0 + n] : 1.0f;
            u32x4 o; o.x = cvt_pk_bf16(sp[0 * 33] * mn, sp[1 * 33] * mn); o.y = cvt_pk_bf16(sp[2 * 33] * mn, sp[3 * 33] * mn); o.z = cvt_pk_bf16(sp[4 * 33] * mn, sp[5 * 33] * mn); o.w = cvt_pk_bf16(sp[6 * 33] * mn, sp[7 * 33] * mn);
            *(u32x4*)(WT + (size_t)(drow0 + n) * K + k0 + 8 * c) = o; }
        LDS_WAIT(); asm volatile("" ::: "memory");
    }
}

__device__ __forceinline__ void scores_phase(const bf16* q, const bf16* k, bf16* Pp, int bid, int G, int wave, int lane) {
    const int g = lane >> 4, l16 = lane & 15, nt = wave >> 1, mt0 = 2 * (wave & 1);
    const int n = 16 * nt + l16, ma = 16 * mt0 + l16, mb = ma + 16;
    const int qo = (((n >> 5) * 2 + (g >> 1)) * 64 + (g & 1) * 32 + (n & 31)) * 8, kao = (((ma >> 5) * 2 + (g >> 1)) * 64 + (g & 1) * 32 + (ma & 31)) * 8, kbo = (((mb >> 5) * 2 + (g >> 1)) * 64 + (g & 1) * 32 + (mb & 31)) * 8;
    bf16x8 nqa[8], nka[8], nkb[8];
    if (bid < 2048) {
#pragma unroll
        for (int s = 0; s < 8; ++s) { nqa[s] = *(const bf16x8*)(q + (size_t)bid * 16384 + qo + 2048 * s); nka[s] = *(const bf16x8*)(k + (size_t)bid * 16384 + kao + 2048 * s); nkb[s] = *(const bf16x8*)(k + (size_t)bid * 16384 + kbo + 2048 * s); } }
    for (int unit = bid; unit < 2048; unit += G) {
        const int bh = unit >> 6, h = bh & 7;
        const float lg2 = head_lg2(h);
        bf16x8 qa[8], ka[8], kb[8];
#pragma unroll
        for (int s = 0; s < 8; ++s) { qa[s] = nqa[s]; ka[s] = nka[s]; kb[s] = nkb[s]; }
        if (unit + G < 2048) { const size_t ub = (size_t)(unit + G) * 16384;
#pragma unroll
            for (int s = 0; s < 8; ++s) { nqa[s] = *(const bf16x8*)(q + ub + qo + 2048 * s); nka[s] = *(const bf16x8*)(k + ub + kao + 2048 * s); nkb[s] = *(const bf16x8*)(k + ub + kbo + 2048 * s); } }
        f32x4 c0 = {0.f, 0.f, 0.f, 0.f}, c1 = {0.f, 0.f, 0.f, 0.f};
#pragma unroll
        for (int s = 0; s < 8; ++s) { c0 = __builtin_amdgcn_mfma_f32_16x16x32_bf16(ka[s], qa[s], c0, 0, 0, 0); c1 = __builtin_amdgcn_mfma_f32_16x16x32_bf16(kb[s], qa[s], c1, 0, 0, 0); }
#pragma unroll
        for (int j = 0; j < 2; ++j) { const f32x4 c = j ? c1 : c0; const int m0 = 16 * (mt0 + j) + 4 * g; float o[4];
#pragma unroll
            for (int i = 0; i < 4; ++i) { const int mm = m0 + i, e = (n > mm ? n - mm : mm - n) - n - 1; o[i] = c[i] * exp2f((float)e * lg2); }
            u32x2 w; w.x = cvt_pk_bf16(o[0], o[1]); w.y = cvt_pk_bf16(o[2], o[3]);
            *(u32x2*)(Pp + (size_t)unit * 4096 + (((n >> 5) * 4 + (m0 >> 4)) * 64 + ((m0 >> 3) & 1) * 32 + (n & 31)) * 8 + (m0 & 7)) = w; }
    }
}

template <int W> __device__ __forceinline__ void pool_item(const bf16* pz, bf16* pin, int t0, int s0, int c8) {
    constexpr int R = 8 + W - 1;
    u32x4 raw[R];
#pragma unroll
    for (int j = 0; j < R; ++j) { const int dj = j - (W - 1); const bool ok = (s0 + dj) >= 0;
        raw[j] = *(const u32x4*)(pz + (size_t)(t0 + (ok ? dj : 0)) * DPOOL + c8 * 8); if (!ok) raw[j] = (u32x4){0u, 0u, 0u, 0u}; }
    u32x4 outw[8];
#pragma unroll
    for (int d = 0; d < 4; ++d) {
        float lo[R], hi[R], slo[8], shi[8];
#pragma unroll
        for (int j = 0; j < R; ++j) { lo[j] = __uint_as_float(raw[j][d] << 16); hi[j] = __uint_as_float(raw[j][d] & 0xffff0000u); }
#pragma unroll
        for (int i = 0; i < 8; ++i) { slo[i] = lo[i + W - 1]; shi[i] = hi[i + W - 1]; }
#pragma unroll
        for (int st = 1; st < W; st *= 2)
#pragma unroll
            for (int j = 0; j + st < R; ++j) { lo[j] += lo[j + st]; hi[j] += hi[j + st]; }
#pragma unroll
        for (int i = 0; i < 8; ++i) { const int cn = (s0 + i + 1) < W ? (s0 + i + 1) : W; const float fc = (float)cn;
            outw[i][d] = cvt_pk_bf16(lo[i] / fc - slo[i], hi[i] / fc - shi[i]); }
    }
#pragma unroll
    for (int i = 0; i < 8; ++i) *(u32x4*)(pin + (size_t)(t0 + i) * DPOOL + c8 * 8) = outw[i];
}
__device__ __forceinline__ void pool_phase(const bf16* pz, bf16* pin, int gw, int NGW, int lane) {
    for (int wi = gw; wi < 4096; wi += NGW) {
        const int g = wi & 3, tb = (wi >> 2) * 2 + (lane >> 5), c8 = g * 32 + (lane & 31), t0 = tb * 8, s0 = t0 & (SEQ - 1);
        if (g == 0) pool_item<2>(pz, pin, t0, s0, c8); else if (g == 1) pool_item<4>(pz, pin, t0, s0, c8); else if (g == 2) pool_item<8>(pz, pin, t0, s0, c8); else pool_item<16>(pz, pin, t0, s0, c8);
    }
}

__device__ __forceinline__ bf16x8 pack_acc8(const f32x16& S, int s) {
    u32x4 w; w.x = cvt_pk_bf16(S[8 * s + 0], S[8 * s + 1]); w.y = cvt_pk_bf16(S[8 * s + 2], S[8 * s + 3]); w.z = cvt_pk_bf16(S[8 * s + 4], S[8 * s + 5]); w.w = cvt_pk_bf16(S[8 * s + 6], S[8 * s + 7]);
    return __builtin_bit_cast(bf16x8, w);
}
__device__ __forceinline__ void scan_phase(const bf16* q, const bf16* kdT, const bf16* vT, const bf16* Pp, bf16* o, LAS unsigned char* lds, int bid, int G, int wave, int lane, int tid) {
    const int rnt = tid >> 8, rj = (tid >> 6) & 3, rhh = (tid >> 5) & 1, rv = tid & 31, rn0 = 32 * rnt + 8 * rj + 4 * rhh;
    for (int unit = bid; unit < 256; unit += G) {
        const int bh = (unit & 7) * 4 + (unit >> 6), vs = (unit >> 3) & 7, b = bh >> 3, h = bh & 7;
        const float lg2 = head_lg2(h), cd = exp2f(64.0f * lg2);
        float qd[4];
#pragma unroll
        for (int e = 0; e < 4; ++e) qd[e] = exp2f((float)(rn0 + e + 1) * lg2);
        const char* kp = (const char*)kdT + ((size_t)bh * 64 * 16384 + wave * 2048) * 2;
        const char* vp = (const char*)vT + ((size_t)bh * 64 * 16384 + vs * 2048) * 2;
        const char* qp = (const char*)q + ((size_t)bh * 64 * 16384 + wave * 2048) * 2;
        const char* pp = (const char*)Pp + ((size_t)bh * 64 * 4096 + wave * 512) * 2;
        const unsigned voff = (unsigned)lane * 16u;
        bf16* op = o + (size_t)(b * SEQ + rn0) * 2048 + h * 256 + 32 * vs + rv;
        const int iks = wave & 3, int_ = wave >> 2;
        const int rboff = ((rnt * 2 + (rj >> 1)) * 64 + rhh * 32 + rv) * 16 + (rj & 1) * 8;
        f32x16 S;
#pragma unroll
        for (int e = 0; e < 16; ++e) S[e] = 0.f;
        bf16x8 kf[2][4], vf[4], vst, qf[3][2][2], pf[3];
#define SCAN_LOADV(VSET, CH) do { const size_t c_ = (size_t)(CH); \
            _Pragma("unroll") for (int s = 0; s < 4; ++s) kf[VSET][s] = *(const bf16x8*)(kp + c_ * 32768 + 1024 * s + voff); } while (0)
#define SCAN_LOAD(SET, CH) do { const size_t c_ = (size_t)(CH); \
            _Pragma("unroll") for (int nt = 0; nt < 2; ++nt) _Pragma("unroll") for (int s = 0; s < 2; ++s) qf[SET][nt][s] = *(const bf16x8*)(qp + c_ * 32768 + nt * 2048 + 1024 * s + voff); \
            pf[SET] = *(const bf16x8*)(pp + c_ * 8192 + voff); } while (0)
#define SCAN_STEP(CS, NS, VC, VN, I) do { const int i_ = (I); const int in_ = i_ + 2 < 64 ? i_ + 2 : 63, iv_ = i_ + 1 < 64 ? i_ + 1 : 63; \
            if (wave < 4) { *(LAS bf16x8*)(lds + 65536 + ((i_ + 1) & 1) * 4096 + wave * 1024 + voff) = vst; vst = *(const bf16x8*)(vp + (size_t)in_ * 32768 + 1024 * wave + voff); } \
            SCAN_LOAD(NS, in_); SCAN_LOADV(VN, iv_); \
            const bf16x8 Bf0 = pack_acc8(S, 0), Bf1 = pack_acc8(S, 1); \
            LAS u32x4* pb = (LAS u32x4*)(lds + (i_ & 1) * 32768 + wave * 4096); \
            _Pragma("unroll") for (int nt = 0; nt < 2; ++nt) { f32x16 p; \
                _Pragma("unroll") for (int e = 0; e < 16; ++e) p[e] = 0.f; \
                p = __builtin_amdgcn_mfma_f32_32x32x16_bf16(qf[CS][nt][0], Bf0, p, 0, 0, 0); p = __builtin_amdgcn_mfma_f32_32x32x16_bf16(qf[CS][nt][1], Bf1, p, 0, 0, 0); \
                if (int_ == nt) { if (iks == 0) p = __builtin_amdgcn_mfma_f32_32x32x16_bf16(pf[CS], vf[0], p, 0, 0, 0); else if (iks == 1) p = __builtin_amdgcn_mfma_f32_32x32x16_bf16(pf[CS], vf[1], p, 0, 0, 0); \
                    else if (iks == 2) p = __builtin_amdgcn_mfma_f32_32x32x16_bf16(pf[CS], vf[2], p, 0, 0, 0); else p = __builtin_amdgcn_mfma_f32_32x32x16_bf16(pf[CS], vf[3], p, 0, 0, 0); } \
                _Pragma("unroll") for (int jp = 0; jp < 2; ++jp) { u32x4 w_; w_.x = cvt_pk_bf16(p[8 * jp], p[8 * jp + 1]); w_.y = cvt_pk_bf16(p[8 * jp + 2], p[8 * jp + 3]); \
                    w_.z = cvt_pk_bf16(p[8 * jp + 4], p[8 * jp + 5]); w_.w = cvt_pk_bf16(p[8 * jp + 6], p[8 * jp + 7]); pb[(2 * nt + jp) * 64 + lane] = w_; } } \
            S = S * cd; \
            _Pragma("unroll") for (int s = 0; s < 4; ++s) S = __builtin_amdgcn_mfma_f32_32x32x16_bf16(kf[VC][s], vf[s], S, 0, 0, 0); \
            LDS_WAIT(); __builtin_amdgcn_s_barrier(); asm volatile("" ::: "memory"); \
            const LAS u32x2* rb = (const LAS u32x2*)(lds + (i_ & 1) * 32768 + rboff); \
            f32x4 a = {0.f, 0.f, 0.f, 0.f}; \
            _Pragma("unroll") for (int w = 0; w < 8; ++w) { const u32x2 x_ = rb[w * 512]; \
                a[0] += __uint_as_float(x_.x << 16); a[1] += __uint_as_float(x_.x & 0xffff0000u); a[2] += __uint_as_float(x_.y << 16); a[3] += __uint_as_float(x_.y & 0xffff0000u); } \
            _Pragma("unroll") for (int e = 0; e < 4; ++e) op[(size_t)i_ * 64 * 2048 + (size_t)e * 2048] = f2bf(a[e] * qd[e]); \
            _Pragma("unroll") for (int s = 0; s < 4; ++s) vf[s] = *(const LAS bf16x8*)(lds + 65536 + ((i_ + 1) & 1) * 4096 + s * 1024 + voff); \
            __builtin_amdgcn_sched_barrier(0); \
        } while (0)
        SCAN_LOAD(0, 0); SCAN_LOAD(1, 1); SCAN_LOADV(0, 0);
        vst = *(const bf16x8*)(vp + 1024 * (wave & 3) + voff);
        if (wave < 4) { *(LAS bf16x8*)(lds + 65536 + wave * 1024 + voff) = vst; vst = *(const bf16x8*)(vp + (size_t)32768 + 1024 * wave + voff); }
        LDS_WAIT(); __builtin_amdgcn_s_barrier(); asm volatile("" ::: "memory");
#pragma unroll
        for (int s = 0; s < 4; ++s) vf[s] = *(const LAS bf16x8*)(lds + 65536 + s * 1024 + voff);
        for (int i = 0; i < 60; i += 6) { SCAN_STEP(0, 2, 0, 1, i); SCAN_STEP(1, 0, 1, 0, i + 1); SCAN_STEP(2, 1, 0, 1, i + 2); SCAN_STEP(0, 2, 1, 0, i + 3); SCAN_STEP(1, 0, 0, 1, i + 4); SCAN_STEP(2, 1, 1, 0, i + 5); }
        SCAN_STEP(0, 2, 0, 1, 60); SCAN_STEP(1, 0, 1, 0, 61); SCAN_STEP(2, 1, 0, 1, 62); SCAN_STEP(0, 2, 1, 0, 63);
#undef SCAN_LOADV
#undef SCAN_STEP
#undef SCAN_LOAD
        __syncthreads();
    }
}

#define XB_TMO      128
#define XB_XCNT(j)  (256  + 64 * (j))
#define XB_XSUB(j)  (1280 + 64 * (j))
#define XB_XGEN(j)  (2304 + 64 * (j))
#define XB_TOP      3328
#define XB_TOPGEN   3392
#define XCD_BAR_WORDS 3456
#define XB_SPIN_CAP (1u << 18)

__device__ __forceinline__ unsigned xb_ld(unsigned* p)              { return __hip_atomic_load(p, __ATOMIC_RELAXED, __HIP_MEMORY_SCOPE_AGENT); }
__device__ __forceinline__ unsigned xb_add(unsigned* p, unsigned v) { return __hip_atomic_fetch_add(p, v, __ATOMIC_RELAXED, __HIP_MEMORY_SCOPE_AGENT); }
__device__ __forceinline__ unsigned xb_xcc_id() { return (unsigned)__builtin_amdgcn_s_getreg((3 << 11) | 20) & 0xFu; }
#define XB_SPIN(cond, bar) do { unsigned _sp = 0; while (cond) { __builtin_amdgcn_s_sleep(1); \
    if ((++_sp & 255u) == 0u) { if (xb_ld(&(bar)[XB_TMO])) break; if (_sp > XB_SPIN_CAP) { atomicAdd(&(bar)[XB_TMO], 1u); break; } } } } while (0)

struct XcdBarrier {
    unsigned* bar; unsigned x;
    volatile LAS unsigned* st;
};

__device__ __forceinline__ XcdBarrier xcd_barrier_post(unsigned* bar, volatile LAS unsigned* st) {
    XcdBarrier b; b.bar = bar; b.x = xb_xcc_id(); b.st = st;
    if (threadIdx.x == 0) (void)xb_add(&bar[XB_XCNT(b.x)], 1u);
    return b;
}
__device__ __forceinline__ void xcd_barrier_complete(unsigned* bar, unsigned x, unsigned& nloc, unsigned& nx) {
    const unsigned G = gridDim.x * gridDim.y * gridDim.z;
    unsigned sum, cnt, mine, sp = 0u;
    for (;;) {
        sum = 0u; cnt = 0u; mine = 0u;
#pragma unroll
        for (unsigned j = 0; j < 16; ++j) { const unsigned c = xb_ld(&bar[XB_XCNT(j)]); sum += c; cnt += (c > 0u) ? 1u : 0u; mine = (j == x) ? c : mine; }
        if (sum == G) break;
        __builtin_amdgcn_s_sleep(1);
        if ((++sp & 255u) == 0u) { if (xb_ld(&bar[XB_TMO])) break; if (sp > XB_SPIN_CAP) { atomicAdd(&bar[XB_TMO], 1u); break; } }
    }
    nloc = mine > 0u ? mine : 1u; nx = cnt > 0u ? cnt : 1u;
}

__device__ __forceinline__ void xcd_barrier(const XcdBarrier& b) {
    asm volatile("s_waitcnt vmcnt(0)" ::: "memory");
    __syncthreads();
    if (threadIdx.x == 0) {
        unsigned* bar = b.bar;
        __builtin_amdgcn_s_waitcnt(0);
        unsigned nloc = b.st[0], nx = b.st[1];
        if (nloc == 0u) { xcd_barrier_complete(bar, b.x, nloc, nx); b.st[0] = nloc; b.st[1] = nx; }
        const unsigned old = xb_add(&bar[XB_XSUB(b.x)], 1u);
        const unsigned gen = old / nloc;
        if (old + 1u == (gen + 1u) * nloc) {
            __builtin_amdgcn_fence(__ATOMIC_RELEASE, "agent");
            asm volatile("s_waitcnt vmcnt(0)" ::: "memory");
            const unsigned og = xb_add(&bar[XB_TOP], 1u);
            const unsigned tg = og / nx;
            if (og + 1u == (tg + 1u) * nx) xb_add(&bar[XB_TOPGEN], 1u);
            else XB_SPIN(xb_ld(&bar[XB_TOPGEN]) == tg, bar);
            __builtin_amdgcn_fence(__ATOMIC_ACQUIRE, "agent");
            xb_add(&bar[XB_XGEN(b.x)], 1u);
            asm volatile("s_waitcnt vmcnt(0)" ::: "memory");
        } else {
            XB_SPIN(xb_ld(&bar[XB_XGEN(b.x)]) == gen, bar);
            __builtin_amdgcn_fence(__ATOMIC_ACQUIRE, "agent");
            asm volatile("s_waitcnt vmcnt(0)" ::: "memory");
        }
    }
    __syncthreads();
}

struct Args { const float* in[12]; float* out; unsigned char* ws; };

__global__ void __launch_bounds__(512, 2) fwd_megakernel(Args a) {
    extern __shared__ __attribute__((aligned(16))) unsigned char lds_raw[];
    cg::grid_group grid = cg::this_grid();
    { LAS unsigned* lc = (LAS unsigned*)((LAS unsigned char*)lds_raw + 131072); if (threadIdx.x < 128) lc[threadIdx.x] = 0u;
      if (blockIdx.x == 0) for (int i = threadIdx.x; i < XCD_BAR_WORDS; i += 512) ((unsigned*)a.ws)[i] = 0u; }
    __syncthreads();
    XcdBarrier xbar; xbar.bar = (unsigned*)a.ws; xbar.x = 0; xbar.st = nullptr;
#define PH_IDS int tid = threadIdx.x; asm volatile("" : "+v"(tid)); const int lane = tid & 63, wave = __builtin_amdgcn_readfirstlane(tid >> 6); \
    const int bid = blockIdx.x, G = gridDim.x, gw = bid * 8 + wave, NGW = G * 8, gtid = bid * 512 + tid, gthreads = G * 512; \
    GAS unsigned char* wsg_ = (GAS unsigned char*)a.ws; asm volatile("" : "+s"(wsg_)); unsigned char* ws = (unsigned char*)wsg_; LAS unsigned char* lds = (LAS unsigned char*)lds_raw; LAS float* scr = (LAS float*)(lds + wave * 16384); \
    (void)lane; (void)gw; (void)NGW; (void)gtid; (void)gthreads; (void)scr; (void)ws; (void)G; (void)bid;

    if constexpr ((PHASES >> 0) & 1) for (int rep_ = 0; rep_ <= ((REPEAT >> 0) & 1); ++rep_) { PH_IDS
        conv_matrix(a.in[2], D, NPROJ, (bf16*)(ws + WS_WIN), a.in[1], nullptr, 0, scr, lane, gw, NGW);
        conv_matrix(a.in[3], D, D, (bf16*)(ws + WS_WRET), nullptr, nullptr, 0, scr, lane, gw, NGW);
        for (int g = 0; g < 4; ++g) conv_matrix(a.in[4] + (size_t)g * 65536, 256, 256, (bf16*)(ws + WS_WPG) + (size_t)g * 65536, nullptr, a.in[5] + 256 * g, 0, scr, lane, gw, NGW);
        conv_matrix(a.in[6], DPOOL, D, (bf16*)(ws + WS_WPB), nullptr, nullptr, 0, scr, lane, gw, NGW);
        conv_matrix(a.in[7], D, D, (bf16*)(ws + WS_WOUT), nullptr, nullptr, 0, scr, lane, gw, NGW);
        float* tcos = (float*)(ws + WS_TCOS); float* tsin = (float*)(ws + WS_TSIN);
        for (int idx = gtid; idx < SEQ * 128; idx += gthreads) {
            const int pos = idx >> 7, d = idx & 127;
            const float invf = 1.0f / powf(10000.0f, (float)(2 * d) * (1.0f / 256.0f));
            const float ang = (float)pos * invf;
            const double rev = (double)ang * 0.15915494309189535; const double fr = rev - rint(rev);
            const float rr = (float)(fr * 6.283185307179586);
            tcos[idx] = cosf(rr); tsin[idx] = sinf(rr);
        }
        const float* x = a.in[0]; bf16* ub = (bf16*)(ws + WS_U);
        f32x4 nv[8];
        if (gw < M) { const f32x4* xr = (const f32x4*)(x + (size_t)gw * D) + lane;
#pragma unroll
            for (int j = 0; j < 8; ++j) nv[j] = xr[64 * j]; }
        for (int m = gw; m < M; m += NGW) {
            f32x4 v[8]; float s = 0.f;
#pragma unroll
            for (int j = 0; j < 8; ++j) { v[j] = nv[j]; s += dot4(v[j]); }
            if (m + NGW < M) { const f32x4* xr = (const f32x4*)(x + (size_t)(m + NGW) * D) + lane;
#pragma unroll
                for (int j = 0; j < 8; ++j) nv[j] = xr[64 * j]; }
            const float rn = 1.0f / sqrtf(wave_sum(s) * (1.0f / 2048.0f) + EPS);
            u32x2* o8 = (u32x2*)(ub + (size_t)m * D) + lane;
#pragma unroll
            for (int j = 0; j < 8; ++j) { u32x2 w; w.x = cvt_pk_bf16(v[j][0] * rn, v[j][1] * rn); w.y = cvt_pk_bf16(v[j][2] * rn, v[j][3] * rn); o8[64 * j] = w; }
        }
    }
    grid.sync();
    xbar = xcd_barrier_post((unsigned*)a.ws, (volatile LAS unsigned*)((LAS unsigned char*)lds_raw + 131072 + 64));

    if constexpr ((PHASES >> 1) & 1) for (int rep_ = 0; rep_ <= ((REPEAT >> 1) & 1); ++rep_) { PH_IDS
        pg8::Gemm g{(const bf16*)(ws + WS_U), (const bf16*)(ws + WS_WIN), D, D, D, 0}; pg8::StaticOrder S; S.init(M, NPROJ, G, bid);
        EpiProj E{(bf16*)(ws + WS_Q), (bf16*)(ws + WS_K), (bf16*)(ws + WS_KDT), (bf16*)(ws + WS_VT), (bf16*)(ws + WS_SRG), (bf16*)(ws + WS_PZ), (bf16*)a.out, (const float*)(ws + WS_TCOS), (const float*)(ws + WS_TSIN)};
        pg8::gemm_phase<EpiProj, pg8::StaticOrder, true, true>(lds, g, S, E);
    }
    xcd_barrier(xbar);

    if constexpr ((PHASES >> 2) & 1) for (int rep_ = 0; rep_ <= ((REPEAT >> 2) & 1); ++rep_) { PH_IDS
        scores_phase((const bf16*)(ws + WS_Q), (const bf16*)(ws + WS_K), (bf16*)(ws + WS_PP), bid, G, wave, lane);
        pool_phase((const bf16*)(ws + WS_PZ), (bf16*)(ws + WS_PIN), gw, NGW, lane);
        conv_matrix(a.in[9], D, 2 * DFF, (bf16*)(ws + WS_WFI), a.in[8], nullptr, 1, scr, lane, gw, NGW);
    }
    xcd_barrier(xbar);

    if constexpr ((PHASES >> 3) & 1) for (int rep_ = 0; rep_ <= ((REPEAT >> 3) & 1); ++rep_) { PH_IDS
        scan_phase((const bf16*)(ws + WS_Q), (const bf16*)(ws + WS_KDT), (const bf16*)(ws + WS_VT), (const bf16*)(ws + WS_PP), (bf16*)(ws + WS_O), lds, bid, G, wave, lane, tid);
    }
    xcd_barrier(xbar);

    if constexpr ((PHASES >> 4) & 1) for (int rep_ = 0; rep_ <= ((REPEAT >> 4) & 1); ++rep_) { PH_IDS
        { pg8::Gemm g{(const bf16*)(ws + WS_PIN), (const bf16*)(ws + WS_WPG), DPOOL, 256, 256, 256}; pg8::StaticOrder S; S.init(M, DPOOL, G, bid);
          EpiPlain E{(bf16*)(ws + WS_P2), DPOOL};
          pg8::gemm_phase<EpiPlain, pg8::StaticOrder, true, true>(lds, g, S, E); }
        const bf16* ob = (const bf16*)(ws + WS_O); const bf16* srg = (const bf16*)(ws + WS_SRG); bf16* og = (bf16*)(ws + WS_OG);
        u32x4 nob[4], nsr[4];
        if (gw < M) {
#pragma unroll
            for (int jj = 0; jj < 4; ++jj) { const int c = jj * 512 + lane * 8; nob[jj] = *(const u32x4*)(ob + (size_t)gw * 2048 + c); nsr[jj] = *(const u32x4*)(srg + (size_t)gw * 2048 + c); } }
        for (int r = gw; r < M; r += NGW) {
            u32x4 cob[4], csr[4];
#pragma unroll
            for (int jj = 0; jj < 4; ++jj) { cob[jj] = nob[jj]; csr[jj] = nsr[jj]; }
            if (r + NGW < M) {
#pragma unroll
                for (int jj = 0; jj < 4; ++jj) { const int c = jj * 512 + lane * 8; nob[jj] = *(const u32x4*)(ob + (size_t)(r + NGW) * 2048 + c); nsr[jj] = *(const u32x4*)(srg + (size_t)(r + NGW) * 2048 + c); } }
#pragma unroll
            for (int jj = 0; jj < 4; ++jj) { const int c = jj * 512 + lane * 8;
                f32x4 o0, o1, s0, s1; unpack8(cob[jj], o0, o1); unpack8(csr[jj], s0, s1);
                float tot = dot4(o0) + dot4(o1);
                tot += __shfl_xor(tot, 1); tot += __shfl_xor(tot, 2); tot += __shfl_xor(tot, 4); tot += __shfl_xor(tot, 8); tot += __shfl_xor(tot, 16);
                const float rn = 1.0f / sqrtf(tot * (1.0f / 256.0f) + EPS);
                *(u32x4*)(og + (size_t)r * 2048 + c) = pack8(o0 * rn * s0, o1 * rn * s1); }
        }
        conv_matrix(a.in[10], DFF, D, (bf16*)(ws + WS_WFO), nullptr, nullptr, 0, scr, lane, gw, NGW);
    }
    xcd_barrier(xbar);

    if constexpr ((PHASES >> 5) & 1) for (int rep_ = 0; rep_ <= ((REPEAT >> 5) & 1); ++rep_) {
        { PH_IDS
          pg8::Gemm g{(const bf16*)(ws + WS_P2), (const bf16*)(ws + WS_WPB), DPOOL, DPOOL, DPOOL, 0}; pg8::StaticOrder S; S.init(M, D, G, bid);
          EpiGate<false> E{(const bf16*)a.out, (bf16*)(ws + WS_TMP), (bf16*)(ws + WS_MERGED)};
          pg8::gemm_phase<EpiGate<false>, pg8::StaticOrder, true, true>(lds, g, S, E); }
        { PH_IDS
          pg8::Gemm g{(const bf16*)(ws + WS_OG), (const bf16*)(ws + WS_WRET), D, D, D, 0}; pg8::StaticOrder S; S.init(M, D, G, bid);
          EpiGate<true> E{(const bf16*)a.out, (bf16*)(ws + WS_TMP), (bf16*)(ws + WS_MERGED)};
          pg8::gemm_phase<EpiGate<true>, pg8::StaticOrder, true, true>(lds, g, S, E); }
    }
    xcd_barrier(xbar);

    if constexpr ((PHASES >> 6) & 1) for (int rep_ = 0; rep_ <= ((REPEAT >> 6) & 1); ++rep_) { PH_IDS
        pg8::Gemm g{(const bf16*)(ws + WS_MERGED), (const bf16*)(ws + WS_WOUT), D, D, D, 0}; pg8::StaticOrder S; S.init(M, D, G, bid);
        EpiRes<true> E{a.in[0], (bf16*)(ws + WS_HB), nullptr, (float*)(ws + WS_PART)};
        pg8::gemm_phase<EpiRes<true>, pg8::StaticOrder, true, true>(lds, g, S, E);
    }
    xcd_barrier(xbar);

    if constexpr ((PHASES >> 7) & 1) for (int rep_ = 0; rep_ <= ((REPEAT >> 7) & 1); ++rep_) { PH_IDS
        pg8::Gemm g{(const bf16*)(ws + WS_HB), (const bf16*)(ws + WS_WFI), D, D, D, 0}; pg8::StaticOrder S; S.init(M, 2 * DFF, G, bid);
        EpiSwiglu E{(const float*)(ws + WS_PART), (bf16*)(ws + WS_ACT)};
        pg8::gemm_phase<EpiSwiglu, pg8::StaticOrder, true, true>(lds, g, S, E);
    }
    xcd_barrier(xbar);

    if constexpr ((PHASES >> 8) & 1) for (int rep_ = 0; rep_ <= ((REPEAT >> 8) & 1); ++rep_) { PH_IDS
        pg8::Gemm g{(const bf16*)(ws + WS_ACT), (const bf16*)(ws + WS_WFO), DFF, DFF, DFF, 0}; pg8::StaticOrder S; S.init(M, D, G, bid);
        EpiRes<false> E{nullptr, (bf16*)(ws + WS_HB), a.out, (float*)(ws + WS_PART2)};
        pg8::gemm_phase<EpiRes<false>, pg8::StaticOrder, true, true>(lds, g, S, E);
    }
    xcd_barrier(xbar);

    if constexpr ((PHASES >> 9) & 1) for (int rep_ = 0; rep_ <= ((REPEAT >> 9) & 1); ++rep_) { PH_IDS
        const float* part2 = (const float*)(ws + WS_PART2); const bf16* hb = (const bf16*)(ws + WS_HB); float* out = a.out; const float* gF = a.in[11];
        u32x4 nh[4]; float npv = 0.f;
        if (gw < M) { npv = part2[(size_t)gw * 32 + (lane & 31)];
#pragma unroll
            for (int jj = 0; jj < 4; ++jj) nh[jj] = *(const u32x4*)(hb + (size_t)gw * 2048 + jj * 512 + lane * 8); }
        for (int r = gw; r < M; r += NGW) {
            u32x4 ch[4]; const float cpv = npv;
#pragma unroll
            for (int jj = 0; jj < 4; ++jj) ch[jj] = nh[jj];
            if (r + NGW < M) { npv = part2[(size_t)(r + NGW) * 32 + (lane & 31)];
#pragma unroll
                for (int jj = 0; jj < 4; ++jj) nh[jj] = *(const u32x4*)(hb + (size_t)(r + NGW) * 2048 + jj * 512 + lane * 8); }
            const float tot = wave_sum(cpv) * 0.5f;
            const float rn = 1.0f / sqrtf(tot * (1.0f / 2048.0f) + EPS);
#pragma unroll
            for (int jj = 0; jj < 4; ++jj) { const int c = jj * 512 + lane * 8;
                f32x4 h0, h1; unpack8(ch[jj], h0, h1);
                *(f32x4*)(out + (size_t)r * 2048 + c) = h0 * rn * *(const f32x4*)(gF + c); *(f32x4*)(out + (size_t)r * 2048 + c + 4) = h1 * rn * *(const f32x4*)(gF + c + 4); }
        }
    }
#undef PH_IDS
}

extern "C" void kernel_launch(void* const* d_in, const int* in_sizes, int n_in, void* d_out, int out_size, void* d_ws, size_t ws_size, hipStream_t stream) {
    static int grid = 0;
    if (grid == 0) {
        if (n_in != 12 || in_sizes[0] != M * D || out_size != M * D || ws_size < WS_END) { fprintf(stderr, "kernel_launch: unexpected shapes (n_in %d, in0 %d, out %d, ws %zu < %zu); nothing launched\n", n_in, n_in > 0 ? in_sizes[0] : -1, out_size, ws_size, (size_t)WS_END); grid = -1; return; }
        int dev = 0, cus = 0, per_cu = 0;
        if (hipGetDevice(&dev) != hipSuccess || hipDeviceGetAttribute(&cus, hipDeviceAttributeMultiprocessorCount, dev) != hipSuccess) { grid = -1; return; }
        if (hipFuncSetAttribute((const void*)fwd_megakernel, hipFuncAttributeMaxDynamicSharedMemorySize, LDS_BYTES) != hipSuccess) { fprintf(stderr, "kernel_launch: hipFuncSetAttribute failed\n"); grid = -1; return; }
        if (hipOccupancyMaxActiveBlocksPerMultiprocessor(&per_cu, (const void*)fwd_megakernel, 512, LDS_BYTES) != hipSuccess || per_cu < 1) { fprintf(stderr, "kernel_launch: occupancy query says %d\n", per_cu); per_cu = 1; }
        (void)hipGetLastError();
        grid = cus * per_cu; if (grid > 256) grid = 256;
    }
    if (grid < 0) return;
    Args a{};
    for (int i = 0; i < 12; ++i) a.in[i] = (const float*)d_in[i];
    a.out = (float*)d_out; a.ws = (unsigned char*)d_ws;
    void* args[] = {&a};
    hipError_t e = hipLaunchCooperativeKernel((const void*)fwd_megakernel, dim3(grid), dim3(512), args, LDS_BYTES, stream);
    if (e != hipSuccess) fprintf(stderr, "kernel_launch: cooperative launch failed: %s (grid %d)\n", hipGetErrorString(e), grid);
}
```

```cpp
#include <hip/hip_runtime.h>
#include <hip/hip_cooperative_groups.h>
#include <cstdio>
#include <cstdint>
namespace cg = cooperative_groups;

namespace pg8 {
#define PG8_LAS __attribute__((address_space(3)))
typedef unsigned short bf16_t;
typedef short bf16x8 __attribute__((ext_vector_type(8)));
typedef float f32x4 __attribute__((ext_vector_type(4)));
typedef unsigned u32x4 __attribute__((ext_vector_type(4)));
constexpr int BM = 256, BK = 64, HALF = 128, HTB = HALF * BK * 2  , STAGE_BYTES = 8 * HTB, NXCD = 8, WGM = 4;

__host__ __device__ __forceinline__ int lds_byte(int r, int c) { const int st = (r >> 4) * 2 + (c >> 5), rr = r & 15, cc = c & 31, ob = rr * 64 + cc * 2; return st * 1024 + (ob ^ (((ob >> 9) & 1) << 5)); }
__host__ __device__ __forceinline__ void stage_rc(int b, int& R, int& C) { const int st = b / 1024, sb = b % 1024, swz = sb ^ (((sb >> 9) & 1) << 5); R = (st >> 1) * 16 + swz / 64; C = (st & 1) * 32 + (swz % 64) / 2; }
__host__ __device__ __forceinline__ int perm32(int rho) { const int n = rho >> 4, i = rho & 15; return 8 * (i >> 2) + 4 * n + (i & 3); }

struct Unit { int pm, pn; };
struct Gemm { const bf16_t* A; const bf16_t* Bt; int lda, ldb, K, a_pn_off; };

struct StaticOrder {
    int nM, nN, nwg, G, c;
    __host__ __device__ void init(int M, int N, int G_, int c_) { nM = M / BM; nN = N / BM; nwg = nM * nN; G = G_; c = c_; }
    __host__ __device__ bool next(int i, Unit& u) const {
        const long L = (long)i * G + c; if (L >= nwg) return false;
        int wgid = (int)L; { const int q = nwg / NXCD, r = nwg % NXCD, xcd = wgid % NXCD, off = wgid / NXCD; wgid = (xcd < r ? xcd * (q + 1) : r * (q + 1) + (xcd - r) * q) + off; }
        const int nig = WGM * nN, gid = wgid / nig, fm = gid * WGM, gsz = (nM - fm) < WGM ? (nM - fm) : WGM;
        u.pm = fm + ((wgid % nig) % gsz); u.pn = (wgid % nig) / gsz; return true;
    }
    __device__ __forceinline__ void a_ready(const Unit&) const {}
    __device__ __forceinline__ void done(const Unit&) const {}
};

typedef __bf16 bf16x2_cv __attribute__((ext_vector_type(2)));
typedef float f32x2_cv __attribute__((ext_vector_type(2)));
__device__ __forceinline__ unsigned cvt_pk_bf16(float lo, float hi) { const f32x2_cv v = {lo, hi}; const bf16x2_cv b = __builtin_convertvector(v, bf16x2_cv); return __builtin_bit_cast(unsigned, b); }

template <class Epi, class Sched, bool ALIGN_EPI = false, bool SP2 = false>
__device__ __forceinline__ void gemm_phase(PG8_LAS unsigned char* lds, const Gemm g, const Sched& S, const Epi& E) {
    int tid_o = threadIdx.x; asm volatile("" : "+v"(tid_o));
    const int tid = tid_o, wid = __builtin_amdgcn_readfirstlane(tid >> 6), lane = tid & 63, wr = wid >> 2, wc = wid & 3, fr = lane & 15, fq = lane >> 4;
    const int K = g.K, nt = K / BK;
    unsigned voffA[2], voffB[2];
#pragma unroll
    for (int i = 0; i < 2; ++i) { int R, C; stage_rc(tid * 16 + i * 8192, R, C); const int Rb = Epi::PERM ? ((R & ~31) + perm32(R & 31)) : R;
        voffA[i] = (unsigned)(R * g.lda + C) * 2u; voffB[i] = (unsigned)(Rb * g.ldb + C) * 2u; }
    const size_t kstep = (size_t)(BK * 2);
    const size_t hA = (size_t)HALF * g.lda * 2, hB = (size_t)HALF * g.ldb * 2;
    const size_t tA = 2 * hA, tB = 2 * hB, pnA = (size_t)g.a_pn_off * 2;
    const unsigned ldsw = (unsigned)wid * 1024u;
    const int aoff = lds_byte(wr * 64 + fr, fq * 8), boff = lds_byte(wc * 32 + fr, fq * 8);
#define PG8_SA(b, h) (((b) * 2 + (h)) * HTB)
#define PG8_SB(b, h) ((4 + (b) * 2 + (h)) * HTB)
#define PG8_STAGE(bufoff, gbase, voff) do { _Pragma("unroll") for (int _i = 0; _i < 2; ++_i) \
        __builtin_amdgcn_global_load_lds((const unsigned*)((const char*)(gbase) + (voff)[_i]), (PG8_LAS unsigned*)(lds + (bufoff) + ldsw + _i * 8192), 16, 0, 0); } while (0)
#define PG8_LDA(dst, b, h) do { _Pragma("unroll") for (int m = 0; m < 4; ++m) _Pragma("unroll") for (int k = 0; k < 2; ++k) dst[m][k] = *(const PG8_LAS bf16x8*)(lds + PG8_SA(b, h) + aoff + m * 2048 + k * 1024); } while (0)
#define PG8_LDB(dst, b, h) do { _Pragma("unroll") for (int n = 0; n < 2; ++n) _Pragma("unroll") for (int k = 0; k < 2; ++k) dst[n][k] = *(const PG8_LAS bf16x8*)(lds + PG8_SB(b, h) + boff + n * 2048 + k * 1024); } while (0)
#define PG8_MMA(ai, bj, At, Bt) do { __builtin_amdgcn_s_setprio(1); _Pragma("unroll") for (int m = 0; m < 4; ++m) _Pragma("unroll") for (int n = 0; n < 2; ++n) _Pragma("unroll") for (int k = 0; k < 2; ++k) \
        acc[ai][bj][m][n] = __builtin_amdgcn_mfma_f32_16x16x32_bf16(Bt[n][k], At[m][k], acc[ai][bj][m][n], 0, 0, 0); __builtin_amdgcn_s_setprio(0); } while (0)
#define PG8_WAIT_V(n) asm volatile("s_waitcnt vmcnt(" #n ")" ::: "memory")
#define PG8_WAIT_L(n) asm volatile("s_waitcnt lgkmcnt(" #n ")" ::: "memory")
#define PG8_BAR __builtin_amdgcn_s_barrier()
#define PG8_SCHED __builtin_amdgcn_sched_barrier(0)
    Unit cur, nxt; int ui = 0;
    if (!S.next(0, cur)) return;
    f32x4 acc[2][2][4][2];
#pragma unroll
    for (int a = 0; a < 2; ++a)
#pragma unroll
        for (int b = 0; b < 2; ++b)
#pragma unroll
            for (int m = 0; m < 4; ++m)
#pragma unroll
                for (int n = 0; n < 2; ++n) acc[a][b][m][n] = (f32x4){0.f, 0.f, 0.f, 0.f};
    bf16x8 At[4][2], B0[2][2], B1[2][2];
    const char* cA = (const char*)g.A + (size_t)cur.pm * tA + (size_t)cur.pn * pnA; const char* cB = (const char*)g.Bt + (size_t)cur.pn * tB;
    S.a_ready(cur);
    if constexpr (SP2) {
        PG8_STAGE(PG8_SB(0, 0), cB, voffB); PG8_STAGE(PG8_SB(0, 1), cB + hB, voffB); PG8_STAGE(PG8_SA(0, 0), cA, voffA); PG8_STAGE(PG8_SA(0, 1), cA + hA, voffA);
        if (wr == 1) PG8_BAR;
        PG8_WAIT_V(2); PG8_BAR;
        PG8_STAGE(PG8_SB(1, 0), cB + kstep, voffB); PG8_STAGE(PG8_SA(1, 0), cA + kstep, voffA); PG8_STAGE(PG8_SB(1, 1), cB + hB + kstep, voffB);
        PG8_WAIT_V(6); PG8_BAR;
    } else {
        PG8_STAGE(PG8_SB(0, 0), cB, voffB); PG8_STAGE(PG8_SA(0, 0), cA, voffA); PG8_STAGE(PG8_SB(0, 1), cB + hB, voffB); PG8_STAGE(PG8_SA(0, 1), cA + hA, voffA);
        if (wr == 1) PG8_BAR;
        PG8_WAIT_V(4); PG8_BAR;
        PG8_STAGE(PG8_SB(1, 0), cB + kstep, voffB); PG8_STAGE(PG8_SA(1, 0), cA + kstep, voffA); PG8_STAGE(PG8_SB(1, 1), cB + hB + kstep, voffB);
        PG8_WAIT_V(6); PG8_BAR;
    }
    for (;;) {
        const bool has_next = S.next(ui + 1, nxt);
        const char* nA = has_next ? (const char*)g.A + (size_t)nxt.pm * tA + (size_t)nxt.pn * pnA : cA; const char* nB = has_next ? (const char*)g.Bt + (size_t)nxt.pn * tB : cB;
#pragma nounroll
        for (int t = 0; t < nt; t += 2) {
            const bool last = (t == nt - 2);
            const char* a1 = cA + (size_t)(t + 1) * kstep;
            const char* a2 = last ? nA : cA + (size_t)(t + 2) * kstep; const char* b2 = last ? nB : cB + (size_t)(t + 2) * kstep;
            const char* a3 = a2 + kstep; const char* b3 = b2 + kstep;
            if (last && has_next) S.a_ready(nxt);
            if constexpr (SP2) {
            PG8_LDB(B0, 0, 0); PG8_LDB(B1, 0, 1); PG8_SCHED; PG8_LDA(At, 0, 0); PG8_STAGE(PG8_SA(1, 1), a1 + hA, voffA);
            PG8_WAIT_V(8); PG8_WAIT_L(0); PG8_BAR; PG8_MMA(0, 0, At, B0); PG8_MMA(0, 1, At, B1); PG8_BAR; PG8_SCHED;
            PG8_LDA(At, 0, 1); PG8_STAGE(PG8_SB(0, 0), b2, voffB); PG8_STAGE(PG8_SB(0, 1), b2 + hB, voffB); PG8_STAGE(PG8_SA(0, 0), a2, voffA);
            PG8_WAIT_V(8); PG8_WAIT_L(0); PG8_BAR; PG8_MMA(1, 0, At, B0); PG8_MMA(1, 1, At, B1); PG8_BAR; PG8_SCHED;
            PG8_LDB(B0, 1, 0); PG8_LDB(B1, 1, 1); PG8_SCHED; PG8_LDA(At, 1, 0); PG8_STAGE(PG8_SA(0, 1), a2 + hA, voffA);
            PG8_WAIT_V(8); PG8_WAIT_L(0); PG8_BAR; PG8_MMA(0, 0, At, B0); PG8_MMA(0, 1, At, B1); PG8_BAR; PG8_SCHED;
            PG8_LDA(At, 1, 1); PG8_STAGE(PG8_SB(1, 0), b3, voffB); PG8_STAGE(PG8_SB(1, 1), b3 + hB, voffB); PG8_STAGE(PG8_SA(1, 0), a3, voffA);
            PG8_WAIT_V(8); PG8_WAIT_L(0); PG8_BAR; PG8_MMA(1, 0, At, B0); PG8_MMA(1, 1, At, B1); PG8_BAR; PG8_SCHED;
            } else {
            PG8_LDB(B0, 0, 0); PG8_SCHED; PG8_LDA(At, 0, 0); PG8_STAGE(PG8_SA(1, 1), a1 + hA, voffA);
            PG8_WAIT_L(8); PG8_BAR; PG8_WAIT_L(0); PG8_MMA(0, 0, At, B0); PG8_BAR; PG8_SCHED;
            PG8_LDB(B1, 0, 1); PG8_STAGE(PG8_SB(0, 0), b2, voffB);
            PG8_BAR; PG8_WAIT_L(0); PG8_MMA(0, 1, At, B1); PG8_BAR;
            PG8_LDA(At, 0, 1); PG8_STAGE(PG8_SA(0, 0), a2, voffA);
            PG8_BAR; PG8_WAIT_L(0); PG8_MMA(1, 0, At, B0); PG8_BAR; PG8_SCHED;
            PG8_STAGE(PG8_SB(0, 1), b2 + hB, voffB);
            PG8_WAIT_V(6); PG8_BAR; PG8_MMA(1, 1, At, B1); PG8_BAR;
            PG8_LDB(B0, 1, 0); PG8_SCHED; PG8_LDA(At, 1, 0); PG8_STAGE(PG8_SA(0, 1), a2 + hA, voffA);
            PG8_WAIT_L(8); PG8_BAR; PG8_WAIT_L(0); PG8_MMA(0, 0, At, B0); PG8_BAR; PG8_SCHED;
            PG8_LDB(B1, 1, 1); PG8_STAGE(PG8_SB(1, 0), b3, voffB);
            PG8_BAR; PG8_WAIT_L(0); PG8_MMA(0, 1, At, B1); PG8_BAR;
            PG8_LDA(At, 1, 1); PG8_STAGE(PG8_SA(1, 0), a3, voffA);
            PG8_BAR; PG8_WAIT_L(0); PG8_MMA(1, 0, At, B0); PG8_BAR; PG8_SCHED;
            PG8_STAGE(PG8_SB(1, 1), b3 + hB, voffB);
            PG8_WAIT_V(6); PG8_BAR; PG8_MMA(1, 1, At, B1); PG8_BAR;
            }
        }
        if constexpr (ALIGN_EPI) { if (wr == 0) PG8_BAR; }
        if constexpr (!Epi::AFTER_DRAIN) { E(acc, cur, wr, wc, fr, fq); S.done(cur); }
        if (!has_next) break;
#pragma unroll
        for (int a = 0; a < 2; ++a)
#pragma unroll
            for (int b = 0; b < 2; ++b)
#pragma unroll
                for (int m = 0; m < 4; ++m)
#pragma unroll
                    for (int n = 0; n < 2; ++n) acc[a][b][m][n] = (f32x4){0.f, 0.f, 0.f, 0.f};
        cur = nxt; cA = nA; cB = nB; ++ui;
        if constexpr (ALIGN_EPI) { if (wr == 1) PG8_BAR; }
    }
    PG8_WAIT_V(0);
    if constexpr (!ALIGN_EPI) { if (wr == 0) PG8_BAR; }
    PG8_BAR;
    if constexpr (Epi::AFTER_DRAIN) { E.fused(acc, cur, wr, wc, fr, fq, lds, wid, lane); S.done(cur); }
#undef PG8_SA
#undef PG8_SB
#undef PG8_STAGE
#undef PG8_LDA
#undef PG8_LDB
#undef PG8_MMA
#undef PG8_WAIT_V
#undef PG8_WAIT_L
#undef PG8_BAR
#undef PG8_SCHED
}
}

using pg8::bf16x8; using pg8::f32x4; using pg8::u32x4; using pg8::cvt_pk_bf16;
typedef unsigned short bf16;
typedef float f32x16 __attribute__((ext_vector_type(16)));
typedef unsigned u32x2 __attribute__((ext_vector_type(2)));
#define LAS __attribute__((address_space(3)))
#define GAS __attribute__((address_space(1)))
#define LDS_WAIT() asm volatile("s_waitcnt lgkmcnt(0)" ::: "memory")

constexpr int M = 16384, D = 2048, SEQ = 4096, NPROJ = 13312, DFF = 5632, DPOOL = 1024;
constexpr float EPS = 1e-6f;
constexpr size_t MiB = 1u << 20;
constexpr size_t WS_TCOS = 1 * MiB, WS_TSIN = 3 * MiB, WS_WPG = 5 * MiB, WS_WRET = 6 * MiB, WS_WPB = 14 * MiB, WS_WOUT = 18 * MiB,
    WS_SS = 26 * MiB, WS_PART = 30 * MiB, WS_PART2 = 32 * MiB,
    WS_WIN = 36 * MiB, WS_WFI = 36 * MiB,
    WS_Q = 88 * MiB, WS_OG = 88 * MiB, WS_ACT = 88 * MiB,
    WS_K = 152 * MiB, WS_O = 152 * MiB, WS_MERGED = 152 * MiB,
    WS_VT = 216 * MiB, WS_TMP = 216 * MiB,
    WS_KDT = 280 * MiB, WS_WFO = 280 * MiB,
    WS_SRG = 344 * MiB, WS_HB = 344 * MiB,
    WS_U = 408 * MiB, WS_PP = 408 * MiB, WS_PIN = 424 * MiB,
    WS_PZ = 472 * MiB, WS_P2 = 472 * MiB,
    WS_END = 504 * MiB;
constexpr int LDS_BYTES = 147456;
#ifndef PHASES
#define PHASES 0x3ff
#endif
#ifndef REPEAT
#define REPEAT 0x0
#endif

__device__ __forceinline__ u32x4 pack8(f32x4 a, f32x4 b) { u32x4 w; w.x = cvt_pk_bf16(a[0], a[1]); w.y = cvt_pk_bf16(a[2], a[3]); w.z = cvt_pk_bf16(b[0], b[1]); w.w = cvt_pk_bf16(b[2], b[3]); return w; }
__device__ __forceinline__ void unpack8(u32x4 w, f32x4& a, f32x4& b) {
    a[0] = __uint_as_float(w.x << 16); a[1] = __uint_as_float(w.x & 0xffff0000u); a[2] = __uint_as_float(w.y << 16); a[3] = __uint_as_float(w.y & 0xffff0000u);
    b[0] = __uint_as_float(w.z << 16); b[1] = __uint_as_float(w.z & 0xffff0000u); b[2] = __uint_as_float(w.w << 16); b[3] = __uint_as_float(w.w & 0xffff0000u); }
__device__ __forceinline__ unsigned short f2bf(float f) { unsigned u = __float_as_uint(f); return (unsigned short)((u + 0x7fffu + ((u >> 16) & 1u)) >> 16); }
__device__ __forceinline__ float sigmoidf_(float x) { return __builtin_amdgcn_rcpf(1.0f + __expf(-x)); }
__device__ __forceinline__ f32x4 sig4(f32x4 v) { f32x4 r; r[0] = sigmoidf_(v[0]); r[1] = sigmoidf_(v[1]); r[2] = sigmoidf_(v[2]); r[3] = sigmoidf_(v[3]); return r; }
__device__ __forceinline__ float dot4(f32x4 a) { return (a[0] * a[0] + a[1] * a[1]) + (a[2] * a[2] + a[3] * a[3]); }
__device__ __forceinline__ float sum4(f32x4 a) { return (a[0] + a[1]) + (a[2] + a[3]); }
__device__ __forceinline__ float wave_sum(float v) {
#pragma unroll
    for (int o = 1; o < 64; o <<= 1) v += __shfl_xor(v, o);
    return v;
}
__device__ __forceinline__ float head_lg2(int h) { return log2f(1.0f - exp2f(-5.0f - (float)h)); }

__device__ __forceinline__ unsigned dpp_xor1(unsigned v) { return (unsigned)__builtin_amdgcn_update_dpp(0, (int)v, 0xB1, 0xF, 0xF, true); }
__device__ __forceinline__ unsigned dpp_xor2(unsigned v) { return (unsigned)__builtin_amdgcn_update_dpp(0, (int)v, 0x4E, 0xF, 0xF, true); }
__device__ __forceinline__ void quad_transpose(unsigned& x0, unsigned& x1, unsigned& x2, unsigned& x3, int b) {
    const bool o1 = (b & 1) != 0, o2 = (b & 2) != 0;
    const unsigned r01 = dpp_xor1(o1 ? x0 : x1), r23 = dpp_xor1(o1 ? x2 : x3);
    if (o1) { x0 = r01; x2 = r23; } else { x1 = r01; x3 = r23; }
    const unsigned r02 = dpp_xor2(o2 ? x0 : x2), r13 = dpp_xor2(o2 ? x1 : x3);
    if (o2) { x0 = r02; x1 = r13; } else { x2 = r02; x3 = r13; }
}
__device__ __forceinline__ void tr_store(bf16* p, int second, f32x4 v0, f32x4 v1, int b) {
    unsigned x0 = cvt_pk_bf16(v0[0], v0[1]), x1 = cvt_pk_bf16(v0[2], v0[3]), x2 = cvt_pk_bf16(v1[0], v1[1]), x3 = cvt_pk_bf16(v1[2], v1[3]);
    quad_transpose(x0, x1, x2, x3, b);
    u32x2 lo, hi; lo.x = __builtin_amdgcn_perm(x1, x0, 0x05040100u); lo.y = __builtin_amdgcn_perm(x3, x2, 0x05040100u);
    hi.x = __builtin_amdgcn_perm(x1, x0, 0x07060302u); hi.y = __builtin_amdgcn_perm(x3, x2, 0x07060302u);
    *(u32x2*)p = lo; *(u32x2*)(p + second) = hi;
}

typedef const f32x4 (&AccRef)[2][2][4][2];

struct EpiProj {
    static constexpr bool PERM = true, AFTER_DRAIN = false;
    bf16 *q, *k, *kdT, *vT, *srg, *pz, *sg; const float *tcos, *tsin;
    __device__ __forceinline__ void operator()(AccRef acc, const pg8::Unit& u, int wr, int wc, int fr, int fq) const {
        const int pn = u.pn, row0 = u.pm * 256 + wr * 64 + fr, cl = wc * 32 + 8 * fq;
        if (pn < 16) {
            const bool isk = pn >= 8; const int h = pn & 7; bf16* dst = isk ? k : q;
            const float lg2 = head_lg2(h);
#pragma unroll
            for (int ai = 0; ai < 2; ++ai) {
                f32x4 tcv[4][2], tsv[4][2];
#pragma unroll
                for (int m = 0; m < 4; ++m) { const int pos_ = (row0 + ai * 128 + m * 16) & 4095; const float* tc = tcos + pos_ * 128 + cl; const float* ts = tsin + pos_ * 128 + cl;
                    tcv[m][0] = *(const f32x4*)tc; tcv[m][1] = *(const f32x4*)(tc + 4); tsv[m][0] = *(const f32x4*)ts; tsv[m][1] = *(const f32x4*)(ts + 4); }
#pragma unroll
                for (int m = 0; m < 4; ++m) {
                    int r = row0 + ai * 128 + m * 16; asm volatile("" : "+v"(r)); const int pos = r & 4095;
                    const f32x4 c0 = tcv[m][0], c1 = tcv[m][1], s0 = tsv[m][0], s1 = tsv[m][1];
                    const f32x4 a0 = acc[ai][0][m][0], a1 = acc[ai][0][m][1], b0 = acc[ai][1][m][0], b1 = acc[ai][1][m][1];
                    const f32x4 o10 = (a0 * c0 - b0 * s0) * 0.0625f, o11 = (a1 * c1 - b1 * s1) * 0.0625f;
                    const f32x4 o20 = (a0 * s0 + b0 * c0) * 0.0625f, o21 = (a1 * s1 + b1 * c1) * 0.0625f;
                    const size_t blk = ((size_t)(((r >> 12) * 8 + h) * 64 + (pos >> 6))) * 16384;
                    const int nn = r & 63;
                    bf16* rp = dst + blk + (size_t)(((((cl >> 5) * 2 + (nn >> 5)) * 2 + ((cl >> 4) & 1)) * 64 + ((cl >> 3) & 1) * 32 + (nn & 31)) * 8);
                    *(u32x4*)rp = pack8(o10, o11); *(u32x4*)(rp + 4 * 2048) = pack8(o20, o21);
                    if (isk) {
                        const float kd = exp2f((float)(63 - (r & 63)) * lg2);
                        const int dq = cl + 2 * (fr & 3), dl = dq & 31, sg2 = (dl & 0x13) | ((dl & 4) << 1) | ((dl & 8) >> 1);
                        bf16* tb = kdT + blk + (size_t)((((dq >> 5) * 4 + m) * 64 + ((fr >> 3) & 1) * 32 + sg2) * 8 + (fr & 4));
                        tr_store(tb, 8, o10 * kd, o11 * kd, fr & 3); tr_store(tb + 4 * 4 * 64 * 8, 8, o20 * kd, o21 * kd, fr & 3);
                    }
                }
                asm volatile("" ::: "memory");
            }
        } else if (pn < 24) {
            const int h = pn - 16;
#pragma unroll
            for (int ai = 0; ai < 2; ++ai)
#pragma unroll
                for (int m = 0; m < 4; ++m) {
                    int r = row0 + ai * 128 + m * 16; asm volatile("" : "+v"(r)); const int pos = r & 4095;
                    const int vq = cl + 2 * (fr & 3);
                    bf16* tb = vT + ((size_t)(((r >> 12) * 8 + h) * 64 + (pos >> 6))) * 16384 + (size_t)((((vq >> 5) * 4 + m) * 64 + ((fr >> 3) & 1) * 32 + (vq & 31)) * 8 + (fr & 4));
                    tr_store(tb, 8, acc[ai][0][m][0], acc[ai][0][m][1], fr & 3); tr_store(tb + 4 * 4 * 64 * 8, 8, acc[ai][1][m][0], acc[ai][1][m][1], fr & 3);
                }
        } else if (pn < 32) {
            const int c0 = (pn - 24) * 256 + cl;
#pragma unroll
            for (int ai = 0; ai < 2; ++ai)
#pragma unroll
                for (int m = 0; m < 4; ++m) { const int r = row0 + ai * 128 + m * 16;
#pragma unroll
                    for (int bj = 0; bj < 2; ++bj) { const f32x4 v0 = acc[ai][bj][m][0], v1 = acc[ai][bj][m][1];
                        *(u32x4*)(srg + (size_t)r * 2048 + c0 + bj * 128) = pack8(v0 * sig4(v0), v1 * sig4(v1)); } }
        } else if (pn < 36) {
            const int c0 = (pn - 32) * 256 + cl;
#pragma unroll
            for (int ai = 0; ai < 2; ++ai)
#pragma unroll
                for (int m = 0; m < 4; ++m) { const int r = row0 + ai * 128 + m * 16;
#pragma unroll
                    for (int bj = 0; bj < 2; ++bj) *(u32x4*)(pz + (size_t)r * 1024 + c0 + bj * 128) = pack8(acc[ai][bj][m][0], acc[ai][bj][m][1]); }
        } else {
            const int c0 = (pn - 36) * 256 + cl;
#pragma unroll
            for (int ai = 0; ai < 2; ++ai)
#pragma unroll
                for (int m = 0; m < 4; ++m) { const int r = row0 + ai * 128 + m * 16;
#pragma unroll
                    for (int bj = 0; bj < 2; ++bj) *(u32x4*)(sg + (size_t)r * 4096 + c0 + bj * 128) = pack8(sig4(acc[ai][bj][m][0]), sig4(acc[ai][bj][m][1])); }
        }
    }
};

struct EpiPlain {
    static constexpr bool PERM = true, AFTER_DRAIN = false;
    bf16* O; int ldc;
    __device__ __forceinline__ void operator()(AccRef acc, const pg8::Unit& u, int wr, int wc, int fr, int fq) const {
        const int row0 = u.pm * 256 + wr * 64 + fr, c0 = u.pn * 256 + wc * 32 + 8 * fq;
#pragma unroll
        for (int ai = 0; ai < 2; ++ai)
#pragma unroll
            for (int m = 0; m < 4; ++m) { const int r = row0 + ai * 128 + m * 16;
#pragma unroll
                for (int bj = 0; bj < 2; ++bj) *(u32x4*)(O + (size_t)r * ldc + c0 + bj * 128) = pack8(acc[ai][bj][m][0], acc[ai][bj][m][1]); }
    }
};

template <bool SECOND> struct EpiGate {
    static constexpr bool PERM = true, AFTER_DRAIN = false;
    const bf16* sg; bf16* tmp; bf16* merged;
    __device__ __forceinline__ void operator()(AccRef acc, const pg8::Unit& u, int wr, int wc, int fr, int fq) const {
        const int row0 = u.pm * 256 + wr * 64 + fr, c0 = u.pn * 256 + wc * 32 + 8 * fq;
#pragma unroll
        for (int ai = 0; ai < 2; ++ai) {
            u32x4 gv[4][2], tv[4][2];
#pragma unroll
            for (int m = 0; m < 4; ++m) { const int r = row0 + ai * 128 + m * 16;
#pragma unroll
                for (int bj = 0; bj < 2; ++bj) { const int c = c0 + bj * 128;
                    gv[m][bj] = *(const u32x4*)(sg + (size_t)r * 4096 + (SECOND ? 0 : 2048) + c);
                    if (SECOND) tv[m][bj] = *(const u32x4*)(tmp + (size_t)r * 2048 + c); } }
#pragma unroll
            for (int m = 0; m < 4; ++m) { const int r = row0 + ai * 128 + m * 16;
#pragma unroll
                for (int bj = 0; bj < 2; ++bj) { const int c = c0 + bj * 128;
                    f32x4 g0, g1; unpack8(gv[m][bj], g0, g1);
                    f32x4 v0 = g0 * acc[ai][bj][m][0], v1 = g1 * acc[ai][bj][m][1];
                    if (SECOND) { f32x4 t0, t1; unpack8(tv[m][bj], t0, t1); v0 += t0; v1 += t1;
                        *(u32x4*)(merged + (size_t)r * 2048 + c) = pack8(v0, v1); }
                    else *(u32x4*)(tmp + (size_t)r * 2048 + c) = pack8(v0, v1); } }
            asm volatile("" ::: "memory"); }
    }
};

template <bool FIRST> struct EpiRes {
    static constexpr bool PERM = true, AFTER_DRAIN = false;
    const float* x; bf16* hb; float* hout; float* part;
    __device__ __forceinline__ void operator()(AccRef acc, const pg8::Unit& u, int wr, int wc, int fr, int fq) const {
        const int row0 = u.pm * 256 + wr * 64 + fr, c0 = u.pn * 256 + wc * 32 + 8 * fq;
#pragma unroll
        for (int ai = 0; ai < 2; ++ai) {
            f32x4 xv[4][2][2]; u32x4 hv[4][2];
#pragma unroll
            for (int m = 0; m < 4; ++m) { const int r = row0 + ai * 128 + m * 16;
#pragma unroll
                for (int bj = 0; bj < 2; ++bj) { const size_t off = (size_t)r * 2048 + c0 + bj * 128;
                    if (FIRST) { xv[m][bj][0] = *(const f32x4*)(x + off); xv[m][bj][1] = *(const f32x4*)(x + off + 4); } else hv[m][bj] = *(const u32x4*)(hb + off); } }
#pragma unroll
            for (int m = 0; m < 4; ++m) { const int r = row0 + ai * 128 + m * 16; float s = 0.f;
#pragma unroll
                for (int bj = 0; bj < 2; ++bj) { const size_t off = (size_t)r * 2048 + c0 + bj * 128;
                    f32x4 h0, h1;
                    if (FIRST) { h0 = xv[m][bj][0] + acc[ai][bj][m][0]; h1 = xv[m][bj][1] + acc[ai][bj][m][1]; }
                    else { unpack8(hv[m][bj], h0, h1); h0 += acc[ai][bj][m][0]; h1 += acc[ai][bj][m][1]; }
                    *(u32x4*)(hb + off) = pack8(h0, h1);
                    s += dot4(h0) + dot4(h1); }
                s += __shfl_xor(s, 16); s += __shfl_xor(s, 32);
                if (fq == 0) part[(size_t)r * 32 + u.pn * 4 + wc] = s; }
            asm volatile("" ::: "memory"); }
    }
};

struct EpiSwiglu {
    static constexpr bool PERM = true, AFTER_DRAIN = false;
    const float* part; bf16* act;
    __device__ __forceinline__ void operator()(AccRef acc, const pg8::Unit& u, int wr, int wc, int fr, int fq) const {
        const int row0 = u.pm * 256 + wr * 64 + fr, c0 = u.pn * 128 + wc * 32 + 8 * fq;
        float r2[2][4];
#pragma unroll
        for (int ai = 0; ai < 2; ++ai)
#pragma unroll
            for (int m = 0; m < 4; ++m) { const int r = row0 + ai * 128 + m * 16;
                const float* pp = part + (size_t)r * 32 + 8 * fq;
                float s = sum4(*(const f32x4*)pp) + sum4(*(const f32x4*)(pp + 4));
                s += __shfl_xor(s, 16); s += __shfl_xor(s, 32);
                r2[ai][m] = 1.0f / sqrtf(s * (1.0f / 2048.0f) + EPS); }
#pragma unroll
        for (int ai = 0; ai < 2; ++ai)
#pragma unroll
            for (int m = 0; m < 4; ++m) { const int r = row0 + ai * 128 + m * 16; const float rr = r2[ai][m];
                const f32x4 a0 = acc[ai][0][m][0] * rr, a1 = acc[ai][0][m][1] * rr, b0 = acc[ai][1][m][0] * rr, b1 = acc[ai][1][m][1] * rr;
                *(u32x4*)(act + (size_t)r * DFF + c0) = pack8(a0 * sig4(a0) * b0, a1 * sig4(a1) * b1); }
    }
};

__device__ __forceinline__ void conv_matrix(const float* W, int K, int N, bf16* WT, const float* sk, const float* sn, int mode, LAS float* scr, int lane, int gw, int NGW) {
    const int nblk = N / 32, nitems = (K / 64) * nblk;
    float v[32];
    int it = gw;
    if (it < nitems) { const int kb = it / nblk, nb = it - kb * nblk; const float* src = W + (size_t)(64 * kb + (lane >> 5)) * N + 32 * nb + (lane & 31);
#pragma unroll
        for (int i = 0; i < 32; ++i) v[i] = src[(size_t)(2 * i) * N]; }
    for (; it < nitems; it += NGW) {
        const int kb = it / nblk, nb = it - kb * nblk, n0 = 32 * nb, k0 = 64 * kb; int drow0 = n0;
        if (mode == 1) drow0 = n0 < DFF ? 256 * (n0 >> 7) + (n0 & 127) : 256 * ((n0 - DFF) >> 7) + 128 + ((n0 - DFF) & 127);
#pragma unroll
        for (int i = 0; i < 32; ++i) { const int kk = 2 * i + (lane >> 5); float t = v[i]; if (sk) t *= sk[k0 + kk]; scr[kk * 33 + (lane & 31)] = t; }
        const int nx = it + NGW;
        if (nx < nitems) { const int kb2 = nx / nblk, nb2 = nx - kb2 * nblk; const float* src = W + (size_t)(64 * kb2 + (lane >> 5)) * N + 32 * nb2 + (lane & 31);
#pragma unroll
            for (int i = 0; i < 32; ++i) v[i] = src[(size_t)(2 * i) * N]; }
        LDS_WAIT(); asm volatile("" ::: "memory");
        const int c = lane & 7;
#pragma unroll
        for (int j = 0; j < 4; ++j) { const int n = (lane >> 3) + 8 * j; const LAS float* sp = scr + (8 * c) * 33 + n; const float mn = sn ? sn[n0 + n] : 1.0f;
            u32x4 o; o.x = cvt_pk_bf16(sp[0 * 33] * mn, sp[1 * 33] * mn); o.y = cvt_pk_bf16(sp[2 * 33] * mn, sp[3 * 33] * mn); o.z = cvt_pk_bf16(sp[4 * 33] * mn, sp[5 * 33] * mn); o.w = cvt_pk_bf16(sp[6 * 33] * mn, sp[7 * 33] * mn);
            *(u32x4*)(WT + (size_t)(drow0 + n) * K + k0 + 8 * c) = o; }
        LDS_WAIT(); asm volatile("" ::: "memory");
    }
}

__device__ __forceinline__ void scores_phase(const bf16* q, const bf16* k, bf16* Pp, int bid, int G, int wave, int lane) {
    const int g = lane >> 4, l16 = lane & 15, nt = wave >> 1, mt0 = 2 * (wave & 1);
    const int n = 16 * nt + l16, ma = 16 * mt0 + l16, mb = ma + 16;
    const int qo = (((n >> 5) * 2 + (g >> 1)) * 64 + (g & 1) * 32 + (n & 31)) * 8, kao = (((ma >> 5) * 2 + (g >> 1)) * 64 + (g & 1) * 32 + (ma & 31)) * 8, kbo = (((mb >> 5) * 2 + (g >> 1)) * 64 + (g & 1) * 32 + (mb & 31)) * 8;
    bf16x8 nqa[8], nka[8], nkb[8];
    if (bid < 2048) {
#pragma unroll
        for (int s = 0; s < 8; ++s) { nqa[s] = *(const bf16x8*)(q + (size_t)bid * 16384 + qo + 2048 * s); nka[s] = *(const bf16x8*)(k + (size_t)bid * 16384 + kao + 2048 * s); nkb[s] = *(const bf16x8*)(k + (size_t)bid * 16384 + kbo + 2048 * s); } }
    for (int unit = bid; unit < 2048; unit += G) {
        const int bh = unit >> 6, h = bh & 7;
        const float lg2 = head_lg2(h);
        bf16x8 qa[8], ka[8], kb[8];
#pragma unroll
        for (int s = 0; s < 8; ++s) { qa[s] = nqa[s]; ka[s] = nka[s]; kb[s] = nkb[s]; }
        if (unit + G < 2048) { const size_t ub = (size_t)(unit + G) * 16384;
#pragma unroll
            for (int s = 0; s < 8; ++s) { nqa[s] = *(const bf16x8*)(q + ub + qo + 2048 * s); nka[s] = *(const bf16x8*)(k + ub + kao + 2048 * s); nkb[s] = *(const bf16x8*)(k + ub + kbo + 2048 * s); } }
        f32x4 c0 = {0.f, 0.f, 0.f, 0.f}, c1 = {0.f, 0.f, 0.f, 0.f};
#pragma unroll
        for (int s = 0; s < 8; ++s) { c0 = __builtin_amdgcn_mfma_f32_16x16x32_bf16(ka[s], qa[s], c0, 0, 0, 0); c1 = __builtin_amdgcn_mfma_f32_16x16x32_bf16(kb[s], qa[s], c1, 0, 0, 0); }
#pragma unroll
        for (int j = 0; j < 2; ++j) { const f32x4 c = j ? c1 : c0; const int m0 = 16 * (mt0 + j) + 4 * g; float o[4];
#pragma unroll
            for (int i = 0; i < 4; ++i) { const int mm = m0 + i, e = (n > mm ? n - mm : mm - n) - n - 1; o[i] = c[i] * exp2f((float)e * lg2); }
            u32x2 w; w.x = cvt_pk_bf16(o[0], o[1]); w.y = cvt_pk_bf16(o[2], o[3]);
            *(u32x2*)(Pp + (size_t)unit * 4096 + (((n >> 5) * 4 + (m0 >> 4)) * 64 + ((m0 >> 3) & 1) * 32 + (n & 31)) * 8 + (m0 & 7)) = w; }
    }
}

template <int W> __device__ __forceinline__ void pool_item(const bf16* pz, bf16* pin, int t0, int s0, int c8) {
    constexpr int R = 8 + W - 1;
    u32x4 raw[R];
#pragma unroll
    for (int j = 0; j < R; ++j) { const int dj = j - (W - 1); const bool ok = (s0 + dj) >= 0;
        raw[j] = *(const u32x4*)(pz + (size_t)(t0 + (ok ? dj : 0)) * DPOOL + c8 * 8); if (!ok) raw[j] = (u32x4){0u, 0u, 0u, 0u}; }
    u32x4 outw[8];
#pragma unroll
    for (int d = 0; d < 4; ++d) {
        float lo[R], hi[R], slo[8], shi[8];
#pragma unroll
        for (int j = 0; j < R; ++j) { lo[j] = __uint_as_float(raw[j][d] << 16); hi[j] = __uint_as_float(raw[j][d] & 0xffff0000u); }
#pragma unroll
        for (int i = 0; i < 8; ++i) { slo[i] = lo[i + W - 1]; shi[i] = hi[i + W - 1]; }
#pragma unroll
        for (int st = 1; st < W; st *= 2)
#pragma unroll
            for (int j = 0; j + st < R; ++j) { lo[j] += lo[j + st]; hi[j] += hi[j + st]; }
#pragma unroll
        for (int i = 0; i < 8; ++i) { const int cn = (s0 + i + 1) < W ? (s0 + i + 1) : W; const float fc = (float)cn;
            outw[i][d] = cvt_pk_bf16(lo[i] / fc - slo[i], hi[i] / fc - shi[i]); }
    }
#pragma unroll
    for (int i = 0; i < 8; ++i) *(u32x4*)(pin + (size_t)(t0 + i) * DPOOL + c8 * 8) = outw[i];
}
__device__ __forceinline__ void pool_phase(const bf16* pz, bf16* pin, int gw, int NGW, int lane) {
    for (int wi = gw; wi < 4096; wi += NGW) {
        const int g = wi & 3, tb = (wi >> 2) * 2 + (lane >> 5), c8 = g * 32 + (lane & 31), t0 = tb * 8, s0 = t0 & (SEQ - 1);
        if (g == 0) pool_item<2>(pz, pin, t0, s0, c8); else if (g == 1) pool_item<4>(pz, pin, t0, s0, c8); else if (g == 2) pool_item<8>(pz, pin, t0, s0, c8); else pool_item<16>(pz, pin, t0, s0, c8);
    }
}

__device__ __forceinline__ bf16x8 pack_acc8(const f32x16& S, int s) {
    u32x4 w; w.x = cvt_pk_bf16(S[8 * s + 0], S[8 * s + 1]); w.y = cvt_pk_bf16(S[8 * s + 2], S[8 * s + 3]); w.z = cvt_pk_bf16(S[8 * s + 4], S[8 * s + 5]); w.w = cvt_pk_bf16(S[8 * s + 6], S[8 * s + 7]);
    return __builtin_bit_cast(bf16x8, w);
}
__device__ __forceinline__ void scan_phase(const bf16* q, const bf16* kdT, const bf16* vT, const bf16* Pp, bf16* o, LAS unsigned char* lds, int bid, int G, int wave, int lane, int tid) {
    const int rnt = tid >> 8, rj = (tid >> 6) & 3, rhh = (tid >> 5) & 1, rv = tid & 31, rn0 = 32 * rnt + 8 * rj + 4 * rhh;
    for (int unit = bid; unit < 256; unit += G) {
        const int bh = (unit & 7) * 4 + (unit >> 6), vs = (unit >> 3) & 7, b = bh >> 3, h = bh & 7;
        const float lg2 = head_lg2(h), cd = exp2f(64.0f * lg2);
        float qd[4];
#pragma unroll
        for (int e = 0; e < 4; ++e) qd[e] = exp2f((float)(rn0 + e + 1) * lg2);
        const char* kp = (const char*)kdT + ((size_t)bh * 64 * 16384 + wave * 2048) * 2;
        const char* vp = (const char*)vT + ((size_t)bh * 64 * 16384 + vs * 2048) * 2;
        const char* qp = (const char*)q + ((size_t)bh * 64 * 16384 + wave * 2048) * 2;
        const char* pp = (const char*)Pp + ((size_t)bh * 64 * 4096 + wave * 512) * 2;
        const unsigned voff = (unsigned)lane * 16u;
        bf16* op = o + (size_t)(b * SEQ + rn0) * 2048 + h * 256 + 32 * vs + rv;
        const int iks = wave & 3, int_ = wave >> 2;
        const int rboff = ((rnt * 2 + (rj >> 1)) * 64 + rhh * 32 + rv) * 16 + (rj & 1) * 8;
        f32x16 S;
#pragma unroll
        for (int e = 0; e < 16; ++e) S[e] = 0.f;
        bf16x8 kf[2][4], vf[4], vst, qf[3][2][2], pf[3];
#define SCAN_LOADV(VSET, CH) do { const size_t c_ = (size_t)(CH); \
            _Pragma("unroll") for (int s = 0; s < 4; ++s) kf[VSET][s] = *(const bf16x8*)(kp + c_ * 32768 + 1024 * s + voff); } while (0)
#define SCAN_LOAD(SET, CH) do { const size_t c_ = (size_t)(CH); \
            _Pragma("unroll") for (int nt = 0; nt < 2; ++nt) _Pragma("unroll") for (int s = 0; s < 2; ++s) qf[SET][nt][s] = *(const bf16x8*)(qp + c_ * 32768 + nt * 2048 + 1024 * s + voff); \
            pf[SET] = *(const bf16x8*)(pp + c_ * 8192 + voff); } while (0)
#define SCAN_STEP(CS, NS, VC, VN, I) do { const int i_ = (I); const int in_ = i_ + 2 < 64 ? i_ + 2 : 63, iv_ = i_ + 1 < 64 ? i_ + 1 : 63; \
            if (wave < 4) { *(LAS bf16x8*)(lds + 65536 + ((i_ + 1) & 1) * 4096 + wave * 1024 + voff) = vst; vst = *(const bf16x8*)(vp + (size_t)in_ * 32768 + 1024 * wave + voff); } \
            SCAN_LOAD(NS, in_); SCAN_LOADV(VN, iv_); \
            const bf16x8 Bf0 = pack_acc8(S, 0), Bf1 = pack_acc8(S, 1); \
            LAS u32x4* pb = (LAS u32x4*)(lds + (i_ & 1) * 32768 + wave * 4096); \
            _Pragma("unroll") for (int nt = 0; nt < 2; ++nt) { f32x16 p; \
                _Pragma("unroll") for (int e = 0; e < 16; ++e) p[e] = 0.f; \
                p = __builtin_amdgcn_mfma_f32_32x32x16_bf16(qf[CS][nt][0], Bf0, p, 0, 0, 0); p = __builtin_amdgcn_mfma_f32_32x32x16_bf16(qf[CS][nt][1], Bf1, p, 0, 0, 0); \
                if (int_ == nt) { if (iks == 0) p = __builtin_amdgcn_mfma_f32_32x32x16_bf16(pf[CS], vf[0], p, 0, 0, 0); else if (iks == 1) p = __builtin_amdgcn_mfma_f32_32x32x16_bf16(pf[CS], vf[1], p, 0, 0, 0); \
                    else if (iks == 2) p = __builtin_amdgcn_mfma_f32_32x32x16_bf16(pf[CS], vf[2], p, 0, 0, 0); else p = __builtin_amdgcn_mfma_f32_32x32x16_bf16(pf[CS], vf[3], p, 0, 0, 0); } \
                _Pragma("unroll") for (int jp = 0; jp < 2; ++jp) { u32x4 w_; w_.x = cvt_pk_bf16(p[8 * jp], p[8 * jp + 1]); w_.y = cvt_pk_bf16(p[8 * jp + 2], p[8 * jp + 3]); \
                    w_.z = cvt_pk_bf16(p[8 * jp + 4], p[8 * jp + 5]); w_.w = cvt_pk_bf16(p[8 * jp + 6], p[8 * jp + 7]); pb[(2 * nt + jp) * 64 + lane] = w_; } } \
            S = S * cd; \
            _Pragma("unroll") for (int s = 0; s < 4; ++s) S = __builtin_amdgcn_mfma_f32_32x32x16_bf16(kf[VC][s], vf[s], S, 0, 0, 0); \
            LDS_WAIT(); __builtin_amdgcn_s_barrier(); asm volatile("" ::: "memory"); \
            const LAS u32x2* rb = (const LAS u32x2*)(lds + (i_ & 1) * 32768 + rboff); \
            f32x4 a = {0.f, 0.f, 0.f, 0.f}; \
            _Pragma("unroll") for (int w = 0; w < 8; ++w) { const u32x2 x_ = rb[w * 512]; \
                a[0] += __uint_as_float(x_.x << 16); a[1] += __uint_as_float(x_.x & 0xffff0000u); a[2] += __uint_as_float(x_.y << 16); a[3] += __uint_as_float(x_.y & 0xffff0000u); } \
            _Pragma("unroll") for (int e = 0; e < 4; ++e) op[(size_t)i_ * 64 * 2048 + (size_t)e * 2048] = f2bf(a[e] * qd[e]); \
            _Pragma("unroll") for (int s = 0; s < 4; ++s) vf[s] = *(const LAS bf16x8*)(lds + 65536 + ((i_ + 1) & 1) * 4096 + s * 1024 + voff); \
            __builtin_amdgcn_sched_barrier(0); \
        } while (0)
        SCAN_LOAD(0, 0); SCAN_LOAD(1, 1); SCAN_LOADV(0, 0);
        vst = *(const bf16x8*)(vp + 1024 * (wave & 3) + voff);
        if (wave < 4) { *(LAS bf16x8*)(lds + 65536 + wave * 1024 + voff) = vst; vst = *(const bf16x8*)(vp + (size_t)32768 + 1024 * wave + voff); }
        LDS_WAIT(); __builtin_amdgcn_s_barrier(); asm volatile("" ::: "memory");
#pragma unroll
        for (int s = 0; s < 4; ++s) vf[s] = *(const LAS bf16x8*)(lds + 65536 + s * 1024 + voff);
        for (int i = 0; i < 60; i += 6) { SCAN_STEP(0, 2, 0, 1, i); SCAN_STEP(1, 0, 1, 0, i + 1); SCAN_STEP(2, 1, 0, 1, i + 2); SCAN_STEP(0, 2, 1, 0, i + 3); SCAN_STEP(1, 0, 0, 1, i + 4); SCAN_STEP(2, 1, 1, 0, i + 5); }
        SCAN_STEP(0, 2, 0, 1, 60); SCAN_STEP(1, 0, 1, 0, 61); SCAN_STEP(2, 1, 0, 1, 62); SCAN_STEP(0, 2, 1, 0, 63);
#undef SCAN_LOADV
#undef SCAN_STEP
#undef SCAN_LOAD
        __syncthreads();
    }
}

#define XB_TMO      128
#define XB_XCNT(j)  (256  + 64 * (j))
#define XB_XSUB(j)  (1280 + 64 * (j))
#define XB_XGEN(j)  (2304 + 64 * (j))
#define XB_TOP      3328
#define XB_TOPGEN   3392
#define XCD_BAR_WORDS 3456
#define XB_SPIN_CAP (1u << 18)

__device__ __forceinline__ unsigned xb_ld(unsigned* p)              { return __hip_atomic_load(p, __ATOMIC_RELAXED, __HIP_MEMORY_SCOPE_AGENT); }
__device__ __forceinline__ unsigned xb_add(unsigned* p, unsigned v) { return __hip_atomic_fetch_add(p, v, __ATOMIC_RELAXED, __HIP_MEMORY_SCOPE_AGENT); }
__device__ __forceinline__ unsigned xb_xcc_id() { return (unsigned)__builtin_amdgcn_s_getreg((3 << 11) | 20) & 0xFu; }
#define XB_SPIN(cond, bar) do { unsigned _sp = 0; while (cond) { __builtin_amdgcn_s_sleep(1); \
    if ((++_sp & 255u) == 0u) { if (xb_ld(&(bar)[XB_TMO])) break; if (_sp > XB_SPIN_CAP) { atomicAdd(&(bar)[XB_TMO], 1u); break; } } } } while (0)

struct XcdBarrier {
    unsigned* bar; unsigned x;
    volatile LAS unsigned* st;
};

__device__ __forceinline__ XcdBarrier xcd_barrier_post(unsigned* bar, volatile LAS unsigned* st) {
    XcdBarrier b; b.bar = bar; b.x = xb_xcc_id(); b.st = st;
    if (threadIdx.x == 0) (void)xb_add(&bar[XB_XCNT(b.x)], 1u);
    return b;
}
__device__ __forceinline__ void xcd_barrier_complete(unsigned* bar, unsigned x, unsigned& nloc, unsigned& nx) {
    const unsigned G = gridDim.x * gridDim.y * gridDim.z;
    unsigned sum, cnt, mine, sp = 0u;
    for (;;) {
        sum = 0u; cnt = 0u; mine = 0u;
#pragma unroll
        for (unsigned j = 0; j < 16; ++j) { const unsigned c = xb_ld(&bar[XB_XCNT(j)]); sum += c; cnt += (c > 0u) ? 1u : 0u; mine = (j == x) ? c : mine; }
        if (sum == G) break;
        __builtin_amdgcn_s_sleep(1);
        if ((++sp & 255u) == 0u) { if (xb_ld(&bar[XB_TMO])) break; if (sp > XB_SPIN_CAP) { atomicAdd(&bar[XB_TMO], 1u); break; } }
    }
    nloc = mine > 0u ? mine : 1u; nx = cnt > 0u ? cnt : 1u;
}

__device__ __forceinline__ void xcd_barrier(const XcdBarrier& b) {
    asm volatile("s_waitcnt vmcnt(0)" ::: "memory");
    __syncthreads();
    if (threadIdx.x == 0) {
        unsigned* bar = b.bar;
        __builtin_amdgcn_s_waitcnt(0);
        unsigned nloc = b.st[0], nx = b.st[1];
        if (nloc == 0u) { xcd_barrier_complete(bar, b.x, nloc, nx); b.st[0] = nloc; b.st[1] = nx; }
        const unsigned old = xb_add(&bar[XB_XSUB(b.x)], 1u);
        const unsigned gen = old / nloc;
        if (old + 1u == (gen + 1u) * nloc) {
            __builtin_amdgcn_fence(__ATOMIC_RELEASE, "agent");
            asm volatile("s_waitcnt vmcnt(0)" ::: "memory");
            const unsigned og = xb_add(&bar[XB_TOP], 1u);
            const unsigned tg = og / nx;
            if (og + 1u == (tg + 1u) * nx) xb_add(&bar[XB_TOPGEN], 1u);
            else XB_SPIN(xb_ld(&bar[XB_TOPGEN]) == tg, bar);
            __builtin_amdgcn_fence(__ATOMIC_ACQUIRE, "agent");
            xb_add(&bar[XB_XGEN(b.x)], 1u);
            asm volatile("s_waitcnt vmcnt(0)" ::: "memory");
        } else {
            XB_SPIN(xb_ld(&bar[XB_XGEN(b.x)]) == gen, bar);
            __builtin_amdgcn_fence(__ATOMIC_ACQUIRE, "agent");
            asm volatile("s_waitcnt vmcnt(0)" ::: "memory");
        }
    }
    __syncthreads();
}

struct Args { const float* in[12]; float* out; unsigned char* ws; };

__global__ void __launch_bounds__(512, 2) fwd_megakernel(Args a) {
    extern __shared__ __attribute__((aligned(16))) unsigned char lds_raw[];
    { LAS unsigned* lc = (LAS unsigned*)((LAS unsigned char*)lds_raw + 131072); if (threadIdx.x < 128) lc[threadIdx.x] = 0u; }
    __syncthreads();
    XcdBarrier xbar = xcd_barrier_post((unsigned*)a.ws, (volatile LAS unsigned*)((LAS unsigned char*)lds_raw + 131072 + 64));
#define PH_IDS int tid = threadIdx.x; asm volatile("" : "+v"(tid)); const int lane = tid & 63, wave = __builtin_amdgcn_readfirstlane(tid >> 6); \
    const int bid = blockIdx.x, G = gridDim.x, gw = bid * 8 + wave, NGW = G * 8, gtid = bid * 512 + tid, gthreads = G * 512; \
    GAS unsigned char* wsg_ = (GAS unsigned char*)a.ws; asm volatile("" : "+s"(wsg_)); unsigned char* ws = (unsigned char*)wsg_; LAS unsigned char* lds = (LAS unsigned char*)lds_raw; LAS float* scr = (LAS float*)(lds + wave * 16384); \
    (void)lane; (void)gw; (void)NGW; (void)gtid; (void)gthreads; (void)scr; (void)ws; (void)G; (void)bid;

    if constexpr ((PHASES >> 0) & 1) for (int rep_ = 0; rep_ <= ((REPEAT >> 0) & 1); ++rep_) { PH_IDS
        conv_matrix(a.in[2], D, NPROJ, (bf16*)(ws + WS_WIN), a.in[1], nullptr, 0, scr, lane, gw, NGW);
        conv_matrix(a.in[3], D, D, (bf16*)(ws + WS_WRET), nullptr, nullptr, 0, scr, lane, gw, NGW);
        for (int g = 0; g < 4; ++g) conv_matrix(a.in[4] + (size_t)g * 65536, 256, 256, (bf16*)(ws + WS_WPG) + (size_t)g * 65536, nullptr, a.in[5] + 256 * g, 0, scr, lane, gw, NGW);
        conv_matrix(a.in[6], DPOOL, D, (bf16*)(ws + WS_WPB), nullptr, nullptr, 0, scr, lane, gw, NGW);
        conv_matrix(a.in[7], D, D, (bf16*)(ws + WS_WOUT), nullptr, nullptr, 0, scr, lane, gw, NGW);
        float* tcos = (float*)(ws + WS_TCOS); float* tsin = (float*)(ws + WS_TSIN);
        for (int idx = gtid; idx < SEQ * 128; idx += gthreads) {
            const int pos = idx >> 7, d = idx & 127;
            const float invf = 1.0f / powf(10000.0f, (float)(2 * d) * (1.0f / 256.0f));
            const float ang = (float)pos * invf;
            const double rev = (double)ang * 0.15915494309189535; const double fr = rev - rint(rev);
            const float rr = (float)(fr * 6.283185307179586);
            tcos[idx] = cosf(rr); tsin[idx] = sinf(rr);
        }
        const float* x = a.in[0]; bf16* ub = (bf16*)(ws + WS_U);
        f32x4 nv[8];
        if (gw < M) { const f32x4* xr = (const f32x4*)(x + (size_t)gw * D) + lane;
#pragma unroll
            for (int j = 0; j < 8; ++j) nv[j] = xr[64 * j]; }
        for (int m = gw; m < M; m += NGW) {
            f32x4 v[8]; float s = 0.f;
#pragma unroll
            for (int j = 0; j < 8; ++j) { v[j] = nv[j]; s += dot4(v[j]); }
            if (m + NGW < M) { const f32x4* xr = (const f32x4*)(x + (size_t)(m + NGW) * D) + lane;
#pragma unroll
                for (int j = 0; j < 8; ++j) nv[j] = xr[64 * j]; }
            const float rn = 1.0f / sqrtf(wave_sum(s) * (1.0f / 2048.0f) + EPS);
            u32x2* o8 = (u32x2*)(ub + (size_t)m * D) + lane;
#pragma unroll
            for (int j = 0; j < 8; ++j) { u32x2 w; w.x = cvt_pk_bf16(v[j][0] * rn, v[j][1] * rn); w.y = cvt_pk_bf16(v[j][2] * rn, v[j][3] * rn); o8[64 * j] = w; }
        }
    }
    xcd_barrier(xbar);

    if constexpr ((PHASES >> 1) & 1) for (int rep_ = 0; rep_ <= ((REPEAT >> 1) & 1); ++rep_) { PH_IDS
        pg8::Gemm g{(const bf16*)(ws + WS_U), (const bf16*)(ws + WS_WIN), D, D, D, 0}; pg8::StaticOrder S; S.init(M, NPROJ, G, bid);
        EpiProj E{(bf16*)(ws + WS_Q), (bf16*)(ws + WS_K), (bf16*)(ws + WS_KDT), (bf16*)(ws + WS_VT), (bf16*)(ws + WS_SRG), (bf16*)(ws + WS_PZ), (bf16*)a.out, (const float*)(ws + WS_TCOS), (const float*)(ws + WS_TSIN)};
        pg8::gemm_phase<EpiProj, pg8::StaticOrder, true, true>(lds, g, S, E);
    }
    xcd_barrier(xbar);

    if constexpr ((PHASES >> 2) & 1) for (int rep_ = 0; rep_ <= ((REPEAT >> 2) & 1); ++rep_) { PH_IDS
        scores_phase((const bf16*)(ws + WS_Q), (const bf16*)(ws + WS_K), (bf16*)(ws + WS_PP), bid, G, wave, lane);
        pool_phase((const bf16*)(ws + WS_PZ), (bf16*)(ws + WS_PIN), gw, NGW, lane);
        conv_matrix(a.in[9], D, 2 * DFF, (bf16*)(ws + WS_WFI), a.in[8], nullptr, 1, scr, lane, gw, NGW);
    }
    xcd_barrier(xbar);

    if constexpr ((PHASES >> 3) & 1) for (int rep_ = 0; rep_ <= ((REPEAT >> 3) & 1); ++rep_) { PH_IDS
        scan_phase((const bf16*)(ws + WS_Q), (const bf16*)(ws + WS_KDT), (const bf16*)(ws + WS_VT), (const bf16*)(ws + WS_PP), (bf16*)(ws + WS_O), lds, bid, G, wave, lane, tid);
    }
    xcd_barrier(xbar);

    if constexpr ((PHASES >> 4) & 1) for (int rep_ = 0; rep_ <= ((REPEAT >> 4) & 1); ++rep_) { PH_IDS
        { pg8::Gemm g{(const bf16*)(ws + WS_PIN), (const bf16*)(ws + WS_WPG), DPOOL, 256, 256, 256}; pg8::StaticOrder S; S.init(M, DPOOL, G, bid);
          EpiPlain E{(bf16*)(ws + WS_P2), DPOOL};
          pg8::gemm_phase<EpiPlain, pg8::StaticOrder, true, true>(lds, g, S, E); }
        const bf16* ob = (const bf16*)(ws + WS_O); const bf16* srg = (const bf16*)(ws + WS_SRG); bf16* og = (bf16*)(ws + WS_OG);
        u32x4 nob[4], nsr[4];
        if (gw < M) {
#pragma unroll
            for (int jj = 0; jj < 4; ++jj) { const int c = jj * 512 + lane * 8; nob[jj] = *(const u32x4*)(ob + (size_t)gw * 2048 + c); nsr[jj] = *(const u32x4*)(srg + (size_t)gw * 2048 + c); } }
        for (int r = gw; r < M; r += NGW) {
            u32x4 cob[4], csr[4];
#pragma unroll
            for (int jj = 0; jj < 4; ++jj) { cob[jj] = nob[jj]; csr[jj] = nsr[jj]; }
            if (r + NGW < M) {
#pragma unroll
                for (int jj = 0; jj < 4; ++jj) { const int c = jj * 512 + lane * 8; nob[jj] = *(const u32x4*)(ob + (size_t)(r + NGW) * 2048 + c); nsr[jj] = *(const u32x4*)(srg + (size_t)(r + NGW) * 2048 + c); } }
#pragma unroll
            for (int jj = 0; jj < 4; ++jj) { const int c = jj * 512 + lane * 8;
                f32x4 o0, o1, s0, s1; unpack8(cob[jj], o0, o1); unpack8(csr[jj], s0, s1);
                float tot = dot4(o0) + dot4(o1);
                tot += __shfl_xor(tot, 1); tot += __shfl_xor(tot, 2); tot += __shfl_xor(tot, 4); tot += __shfl_xor(tot, 8); tot += __shfl_xor(tot, 16);
                const float rn = 1.0f / sqrtf(tot * (1.0f / 256.0f) + EPS);
                *(u32x4*)(og + (size_t)r * 2048 + c) = pack8(o0 * rn * s0, o1 * rn * s1); }
        }
        conv_matrix(a.in[10], DFF, D, (bf16*)(ws + WS_WFO), nullptr, nullptr, 0, scr, lane, gw, NGW);
    }
    xcd_barrier(xbar);

    if constexpr ((PHASES >> 5) & 1) for (int rep_ = 0; rep_ <= ((REPEAT >> 5) & 1); ++rep_) {
        { PH_IDS
          pg8::Gemm g{(const bf16*)(ws + WS_P2), (const bf16*)(ws + WS_WPB), DPOOL, DPOOL, DPOOL, 0}; pg8::StaticOrder S; S.init(M, D, G, bid);
          EpiGate<false> E{(const bf16*)a.out, (bf16*)(ws + WS_TMP), (bf16*)(ws + WS_MERGED)};
          pg8::gemm_phase<EpiGate<false>, pg8::StaticOrder, true, true>(lds, g, S, E); }
        { PH_IDS
          pg8::Gemm g{(const bf16*)(ws + WS_OG), (const bf16*)(ws + WS_WRET), D, D, D, 0}; pg8::StaticOrder S; S.init(M, D, G, bid);
          EpiGate<true> E{(const bf16*)a.out, (bf16*)(ws + WS_TMP), (bf16*)(ws + WS_MERGED)};
          pg8::gemm_phase<EpiGate<true>, pg8::StaticOrder, true, true>(lds, g, S, E); }
    }
    xcd_barrier(xbar);

    if constexpr ((PHASES >> 6) & 1) for (int rep_ = 0; rep_ <= ((REPEAT >> 6) & 1); ++rep_) { PH_IDS
        pg8::Gemm g{(const bf16*)(ws + WS_MERGED), (const bf16*)(ws + WS_WOUT), D, D, D, 0}; pg8::StaticOrder S; S.init(M, D, G, bid);
        EpiRes<true> E{a.in[0], (bf16*)(ws + WS_HB), nullptr, (float*)(ws + WS_PART)};
        pg8::gemm_phase<EpiRes<true>, pg8::StaticOrder, true, true>(lds, g, S, E);
    }
    xcd_barrier(xbar);

    if constexpr ((PHASES >> 7) & 1) for (int rep_ = 0; rep_ <= ((REPEAT >> 7) & 1); ++rep_) { PH_IDS
        pg8::Gemm g{(const bf16*)(ws + WS_HB), (const bf16*)(ws + WS_WFI), D, D, D, 0}; pg8::StaticOrder S; S.init(M, 2 * DFF, G, bid);
        EpiSwiglu E{(const float*)(ws + WS_PART), (bf16*)(ws + WS_ACT)};
        pg8::gemm_phase<EpiSwiglu, pg8::StaticOrder, true, true>(lds, g, S, E);
    }
    xcd_barrier(xbar);

    if constexpr ((PHASES >> 8) & 1) for (int rep_ = 0; rep_ <= ((REPEAT >> 8) & 1); ++rep_) { PH_IDS
        pg8::Gemm g{(const bf16*)(ws + WS_ACT), (const bf16*)(ws + WS_WFO), DFF, DFF, DFF, 0}; pg8::StaticOrder S; S.init(M, D, G, bid);
        EpiRes<false> E{nullptr, (bf16*)(ws + WS_HB), a.out, (float*)(ws + WS_PART2)};
        pg8::gemm_phase<EpiRes<false>, pg8::StaticOrder, true, true>(lds, g, S, E);
    }
    xcd_barrier(xbar);

    if constexpr ((PHASES >> 9) & 1) for (int rep_ = 0; rep_ <= ((REPEAT >> 9) & 1); ++rep_) { PH_IDS
        const float* part2 = (const float*)(ws + WS_PART2); const bf16* hb = (const bf16*)(ws + WS_HB); float* out = a.out; const float* gF = a.in[11];
        u32x4 nh[4]; float npv = 0.f;
        if (gw < M) { npv = part2[(size_t)gw * 32 + (lane & 31)];
#pragma unroll
            for (int jj = 0; jj < 4; ++jj) nh[jj] = *(const u32x4*)(hb + (size_t)gw * 2048 + jj * 512 + lane * 8); }
        for (int r = gw; r < M; r += NGW) {
            u32x4 ch[4]; const float cpv = npv;
#pragma unroll
            for (int jj = 0; jj < 4; ++jj) ch[jj] = nh[jj];
            if (r + NGW < M) { npv = part2[(size_t)(r + NGW) * 32 + (lane & 31)];
#pragma unroll
                for (int jj = 0; jj < 4; ++jj) nh[jj] = *(const u32x4*)(hb + (size_t)(r + NGW) * 2048 + jj * 512 + lane * 8); }
            const float tot = wave_sum(cpv) * 0.5f;
            const float rn = 1.0f / sqrtf(tot * (1.0f / 2048.0f) + EPS);
#pragma unroll
            for (int jj = 0; jj < 4; ++jj) { const int c = jj * 512 + lane * 8;
                f32x4 h0, h1; unpack8(ch[jj], h0, h1);
                *(f32x4*)(out + (size_t)r * 2048 + c) = h0 * rn * *(const f32x4*)(gF + c); *(f32x4*)(out + (size_t)r * 2048 + c + 4) = h1 * rn * *(const f32x4*)(gF + c + 4); }
        }
    }
#undef PH_IDS
}

extern "C" void kernel_launch(void* const* d_in, const int* in_sizes, int n_in, void* d_out, int out_size, void* d_ws, size_t ws_size, hipStream_t stream) {
    static int grid = 0;
    if (grid == 0) {
        if (n_in != 12 || in_sizes[0] != M * D || out_size != M * D || ws_size < WS_END) { fprintf(stderr, "kernel_launch: unexpected shapes (n_in %d, in0 %d, out %d, ws %zu < %zu); nothing launched\n", n_in, n_in > 0 ? in_sizes[0] : -1, out_size, ws_size, (size_t)WS_END); grid = -1; return; }
        int dev = 0, cus = 0, per_cu = 0;
        if (hipGetDevice(&dev) != hipSuccess || hipDeviceGetAttribute(&cus, hipDeviceAttributeMultiprocessorCount, dev) != hipSuccess) { grid = -1; return; }
        if (hipFuncSetAttribute((const void*)fwd_megakernel, hipFuncAttributeMaxDynamicSharedMemorySize, LDS_BYTES) != hipSuccess) { fprintf(stderr, "kernel_launch: hipFuncSetAttribute failed\n"); grid = -1; return; }
        if (hipOccupancyMaxActiveBlocksPerMultiprocessor(&per_cu, (const void*)fwd_megakernel, 512, LDS_BYTES) != hipSuccess || per_cu < 1) { fprintf(stderr, "kernel_launch: occupancy query says %d\n", per_cu); per_cu = 1; }
        (void)hipGetLastError();
        grid = cus * per_cu; if (grid > 256) grid = 256;
    }
    if (grid < 0) return;
    if (hipMemsetAsync(d_ws, 0, 16384, stream) != hipSuccess) { fprintf(stderr, "kernel_launch: hipMemsetAsync of the barrier words failed; nothing launched\n"); return; }
    Args a{};
    for (int i = 0; i < 12; ++i) a.in[i] = (const float*)d_in[i];
    a.out = (float*)d_out; a.ws = (unsigned char*)d_ws;
    void* args[] = {&a};
    hipError_t e = hipLaunchCooperativeKernel((const void*)fwd_megakernel, dim3(grid), dim3(512), args, LDS_BYTES, stream);
    if (e != hipSuccess) fprintf(stderr, "kernel_launch: cooperative launch failed: %s (grid %d)\n", hipGetErrorString(e), grid);
}
```

```cpp
#include <hip/hip_runtime.h>
#include <hip/hip_cooperative_groups.h>
#include <cstdio>
#include <cstdint>
namespace cg = cooperative_groups;

namespace pg8 {
#define PG8_LAS __attribute__((address_space(3)))
typedef unsigned short bf16_t;
typedef short bf16x8 __attribute__((ext_vector_type(8)));
typedef float f32x4 __attribute__((ext_vector_type(4)));
typedef unsigned u32x4 __attribute__((ext_vector_type(4)));
constexpr int BM = 256, BK = 64, HALF = 128, HTB = HALF * BK * 2  , STAGE_BYTES = 8 * HTB, NXCD = 8, WGM = 4;

__host__ __device__ __forceinline__ int lds_byte(int r, int c) { const int st = (r >> 4) * 2 + (c >> 5), rr = r & 15, cc = c & 31, ob = rr * 64 + cc * 2; return st * 1024 + (ob ^ (((ob >> 9) & 1) << 5)); }
__host__ __device__ __forceinline__ void stage_rc(int b, int& R, int& C) { const int st = b / 1024, sb = b % 1024, swz = sb ^ (((sb >> 9) & 1) << 5); R = (st >> 1) * 16 + swz / 64; C = (st & 1) * 32 + (swz % 64) / 2; }
__host__ __device__ __forceinline__ int perm32(int rho) { const int n = rho >> 4, i = rho & 15; return 8 * (i >> 2) + 4 * n + (i & 3); }

struct Unit { int pm, pn; };
struct Gemm { const bf16_t* A; const bf16_t* Bt; int lda, ldb, K, a_pn_off; };

struct StaticOrder {
    int nM, nN, nwg, G, c;
    __host__ __device__ void init(int M, int N, int G_, int c_) { nM = M / BM; nN = N / BM; nwg = nM * nN; G = G_; c = c_; }
    __host__ __device__ bool next(int i, Unit& u) const {
        const long L = (long)i * G + c; if (L >= nwg) return false;
        int wgid = (int)L; { const int q = nwg / NXCD, r = nwg % NXCD, xcd = wgid % NXCD, off = wgid / NXCD; wgid = (xcd < r ? xcd * (q + 1) : r * (q + 1) + (xcd - r) * q) + off; }
        const int nig = WGM * nN, gid = wgid / nig, fm = gid * WGM, gsz = (nM - fm) < WGM ? (nM - fm) : WGM;
        u.pm = fm + ((wgid % nig) % gsz); u.pn = (wgid % nig) / gsz; return true;
    }
    __device__ __forceinline__ void a_ready(const Unit&) const {}
    __device__ __forceinline__ void done(const Unit&) const {}
};

typedef __bf16 bf16x2_cv __attribute__((ext_vector_type(2)));
typedef float f32x2_cv __attribute__((ext_vector_type(2)));
__device__ __forceinline__ unsigned cvt_pk_bf16(float lo, float hi) { const f32x2_cv v = {lo, hi}; const bf16x2_cv b = __builtin_convertvector(v, bf16x2_cv); return __builtin_bit_cast(unsigned, b); }

template <class Epi, class Sched, bool ALIGN_EPI = false, bool SP2 = false>
__device__ __forceinline__ void gemm_phase(PG8_LAS unsigned char* lds, const Gemm g, const Sched& S, const Epi& E) {
    int tid_o = threadIdx.x; asm volatile("" : "+v"(tid_o));
    const int tid = tid_o, wid = __builtin_amdgcn_readfirstlane(tid >> 6), lane = tid & 63, wr = wid >> 2, wc = wid & 3, fr = lane & 15, fq = lane >> 4;
    const int K = g.K, nt = K / BK;
    unsigned voffA[2], voffB[2];
#pragma unroll
    for (int i = 0; i < 2; ++i) { int R, C; stage_rc(tid * 16 + i * 8192, R, C); const int Rb = Epi::PERM ? ((R & ~31) + perm32(R & 31)) : R;
        voffA[i] = (unsigned)(R * g.lda + C) * 2u; voffB[i] = (unsigned)(Rb * g.ldb + C) * 2u; }
    const size_t kstep = (size_t)(BK * 2);
    const size_t hA = (size_t)HALF * g.lda * 2, hB = (size_t)HALF * g.ldb * 2;
    const size_t tA = 2 * hA, tB = 2 * hB, pnA = (size_t)g.a_pn_off * 2;
    const unsigned ldsw = (unsigned)wid * 1024u;
    const int aoff = lds_byte(wr * 64 + fr, fq * 8), boff = lds_byte(wc * 32 + fr, fq * 8);
#define PG8_SA(b, h) (((b) * 2 + (h)) * HTB)
#define PG8_SB(b, h) ((4 + (b) * 2 + (h)) * HTB)
#define PG8_STAGE(bufoff, gbase, voff) do { _Pragma("unroll") for (int _i = 0; _i < 2; ++_i) \
        __builtin_amdgcn_global_load_lds((const unsigned*)((const char*)(gbase) + (voff)[_i]), (PG8_LAS unsigned*)(lds + (bufoff) + ldsw + _i * 8192), 16, 0, 0); } while (0)
#define PG8_LDA(dst, b, h) do { _Pragma("unroll") for (int m = 0; m < 4; ++m) _Pragma("unroll") for (int k = 0; k < 2; ++k) dst[m][k] = *(const PG8_LAS bf16x8*)(lds + PG8_SA(b, h) + aoff + m * 2048 + k * 1024); } while (0)
#define PG8_LDB(dst, b, h) do { _Pragma("unroll") for (int n = 0; n < 2; ++n) _Pragma("unroll") for (int k = 0; k < 2; ++k) dst[n][k] = *(const PG8_LAS bf16x8*)(lds + PG8_SB(b, h) + boff + n * 2048 + k * 1024); } while (0)
#define PG8_MMA(ai, bj, At, Bt) do { __builtin_amdgcn_s_setprio(1); _Pragma("unroll") for (int m = 0; m < 4; ++m) _Pragma("unroll") for (int n = 0; n < 2; ++n) _Pragma("unroll") for (int k = 0; k < 2; ++k) \
        acc[ai][bj][m][n] = __builtin_amdgcn_mfma_f32_16x16x32_bf16(Bt[n][k], At[m][k], acc[ai][bj][m][n], 0, 0, 0); __builtin_amdgcn_s_setprio(0); } while (0)
#define PG8_WAIT_V(n) asm volatile("s_waitcnt vmcnt(" #n ")" ::: "memory")
#define PG8_WAIT_L(n) asm volatile("s_waitcnt lgkmcnt(" #n ")" ::: "memory")
#define PG8_BAR __builtin_amdgcn_s_barrier()
#define PG8_SCHED __builtin_amdgcn_sched_barrier(0)
    Unit cur, nxt; int ui = 0;
    if (!S.next(0, cur)) return;
    f32x4 acc[2][2][4][2];
#pragma unroll
    for (int a = 0; a < 2; ++a)
#pragma unroll
        for (int b = 0; b < 2; ++b)
#pragma unroll
            for (int m = 0; m < 4; ++m)
#pragma unroll
                for (int n = 0; n < 2; ++n) acc[a][b][m][n] = (f32x4){0.f, 0.f, 0.f, 0.f};
    bf16x8 At[4][2], B0[2][2], B1[2][2];
    const char* cA = (const char*)g.A + (size_t)cur.pm * tA + (size_t)cur.pn * pnA; const char* cB = (const char*)g.Bt + (size_t)cur.pn * tB;
    S.a_ready(cur);
    if constexpr (SP2) {
        PG8_STAGE(PG8_SB(0, 0), cB, voffB); PG8_STAGE(PG8_SB(0, 1), cB + hB, voffB); PG8_STAGE(PG8_SA(0, 0), cA, voffA); PG8_STAGE(PG8_SA(0, 1), cA + hA, voffA);
        if (wr == 1) PG8_BAR;
        PG8_WAIT_V(2); PG8_BAR;
        PG8_STAGE(PG8_SB(1, 0), cB + kstep, voffB); PG8_STAGE(PG8_SA(1, 0), cA + kstep, voffA); PG8_STAGE(PG8_SB(1, 1), cB + hB + kstep, voffB);
        PG8_WAIT_V(6); PG8_BAR;
    } else {
        PG8_STAGE(PG8_SB(0, 0), cB, voffB); PG8_STAGE(PG8_SA(0, 0), cA, voffA); PG8_STAGE(PG8_SB(0, 1), cB + hB, voffB); PG8_STAGE(PG8_SA(0, 1), cA + hA, voffA);
        if (wr == 1) PG8_BAR;
        PG8_WAIT_V(4); PG8_BAR;
        PG8_STAGE(PG8_SB(1, 0), cB + kstep, voffB); PG8_STAGE(PG8_SA(1, 0), cA + kstep, voffA); PG8_STAGE(PG8_SB(1, 1), cB + hB + kstep, voffB);
        PG8_WAIT_V(6); PG8_BAR;
    }
    for (;;) {
        const bool has_next = S.next(ui + 1, nxt);
        const char* nA = has_next ? (const char*)g.A + (size_t)nxt.pm * tA + (size_t)nxt.pn * pnA : cA; const char* nB = has_next ? (const char*)g.Bt + (size_t)nxt.pn * tB : cB;
#pragma nounroll
        for (int t = 0; t < nt; t += 2) {
            const bool last = (t == nt - 2);
            const char* a1 = cA + (size_t)(t + 1) * kstep;
            const char* a2 = last ? nA : cA + (size_t)(t + 2) * kstep; const char* b2 = last ? nB : cB + (size_t)(t + 2) * kstep;
            const char* a3 = a2 + kstep; const char* b3 = b2 + kstep;
            if (last && has_next) S.a_ready(nxt);
            if constexpr (SP2) {
            PG8_LDB(B0, 0, 0); PG8_LDB(B1, 0, 1); PG8_SCHED; PG8_LDA(At, 0, 0); PG8_STAGE(PG8_SA(1, 1), a1 + hA, voffA);
            PG8_WAIT_V(8); PG8_WAIT_L(0); PG8_BAR; PG8_MMA(0, 0, At, B0); PG8_MMA(0, 1, At, B1); PG8_BAR; PG8_SCHED;
            PG8_LDA(At, 0, 1); PG8_STAGE(PG8_SB(0, 0), b2, voffB); PG8_STAGE(PG8_SB(0, 1), b2 + hB, voffB); PG8_STAGE(PG8_SA(0, 0), a2, voffA);
            PG8_WAIT_V(8); PG8_WAIT_L(0); PG8_BAR; PG8_MMA(1, 0, At, B0); PG8_MMA(1, 1, At, B1); PG8_BAR; PG8_SCHED;
            PG8_LDB(B0, 1, 0); PG8_LDB(B1, 1, 1); PG8_SCHED; PG8_LDA(At, 1, 0); PG8_STAGE(PG8_SA(0, 1), a2 + hA, voffA);
            PG8_WAIT_V(8); PG8_WAIT_L(0); PG8_BAR; PG8_MMA(0, 0, At, B0); PG8_MMA(0, 1, At, B1); PG8_BAR; PG8_SCHED;
            PG8_LDA(At, 1, 1); PG8_STAGE(PG8_SB(1, 0), b3, voffB); PG8_STAGE(PG8_SB(1, 1), b3 + hB, voffB); PG8_STAGE(PG8_SA(1, 0), a3, voffA);
            PG8_WAIT_V(8); PG8_WAIT_L(0); PG8_BAR; PG8_MMA(1, 0, At, B0); PG8_MMA(1, 1, At, B1); PG8_BAR; PG8_SCHED;
            } else {
            PG8_LDB(B0, 0, 0); PG8_SCHED; PG8_LDA(At, 0, 0); PG8_STAGE(PG8_SA(1, 1), a1 + hA, voffA);
            PG8_WAIT_L(8); PG8_BAR; PG8_WAIT_L(0); PG8_MMA(0, 0, At, B0); PG8_BAR; PG8_SCHED;
            PG8_LDB(B1, 0, 1); PG8_STAGE(PG8_SB(0, 0), b2, voffB);
            PG8_BAR; PG8_WAIT_L(0); PG8_MMA(0, 1, At, B1); PG8_BAR;
            PG8_LDA(At, 0, 1); PG8_STAGE(PG8_SA(0, 0), a2, voffA);
            PG8_BAR; PG8_WAIT_L(0); PG8_MMA(1, 0, At, B0); PG8_BAR; PG8_SCHED;
            PG8_STAGE(PG8_SB(0, 1), b2 + hB, voffB);
            PG8_WAIT_V(6); PG8_BAR; PG8_MMA(1, 1, At, B1); PG8_BAR;
            PG8_LDB(B0, 1, 0); PG8_SCHED; PG8_LDA(At, 1, 0); PG8_STAGE(PG8_SA(0, 1), a2 + hA, voffA);
            PG8_WAIT_L(8); PG8_BAR; PG8_WAIT_L(0); PG8_MMA(0, 0, At, B0); PG8_BAR; PG8_SCHED;
            PG8_LDB(B1, 1, 1); PG8_STAGE(PG8_SB(1, 0), b3, voffB);
            PG8_BAR; PG8_WAIT_L(0); PG8_MMA(0, 1, At, B1); PG8_BAR;
            PG8_LDA(At, 1, 1); PG8_STAGE(PG8_SA(1, 0), a3, voffA);
            PG8_BAR; PG8_WAIT_L(0); PG8_MMA(1, 0, At, B0); PG8_BAR; PG8_SCHED;
            PG8_STAGE(PG8_SB(1, 1), b3 + hB, voffB);
            PG8_WAIT_V(6); PG8_BAR; PG8_MMA(1, 1, At, B1); PG8_BAR;
            }
        }
        if constexpr (ALIGN_EPI) { if (wr == 0) PG8_BAR; }
        if constexpr (!Epi::AFTER_DRAIN) { E(acc, cur, wr, wc, fr, fq); S.done(cur); }
        if (!has_next) break;
#pragma unroll
        for (int a = 0; a < 2; ++a)
#pragma unroll
            for (int b = 0; b < 2; ++b)
#pragma unroll
                for (int m = 0; m < 4; ++m)
#pragma unroll
                    for (int n = 0; n < 2; ++n) acc[a][b][m][n] = (f32x4){0.f, 0.f, 0.f, 0.f};
        cur = nxt; cA = nA; cB = nB; ++ui;
        if constexpr (ALIGN_EPI) { if (wr == 1) PG8_BAR; }
    }
    PG8_WAIT_V(0);
    if constexpr (!ALIGN_EPI) { if (wr == 0) PG8_BAR; }
    PG8_BAR;
    if constexpr (Epi::AFTER_DRAIN) { E.fused(acc, cur, wr, wc, fr, fq, lds, wid, lane); S.done(cur); }
#undef PG8_SA
#undef PG8_SB
#undef PG8_STAGE
#undef PG8_LDA
#undef PG8_LDB
#undef PG8_MMA
#undef PG8_WAIT_V
#undef PG8_WAIT_L
#undef PG8_BAR
#undef PG8_SCHED
}
}

using pg8::bf16x8; using pg8::f32x4; using pg8::u32x4; using pg8::cvt_pk_bf16;
typedef unsigned short bf16;
typedef float f32x16 __attribute__((ext_vector_type(16)));
typedef unsigned u32x2 __attribute__((ext_vector_type(2)));
#define LAS __attribute__((address_space(3)))
#define GAS __attribute__((address_space(1)))
#define LDS_WAIT() asm volatile("s_waitcnt lgkmcnt(0)" ::: "memory")

constexpr int M = 16384, D = 2048, SEQ = 4096, NPROJ = 13312, DFF = 5632, DPOOL = 1024;
constexpr float EPS = 1e-6f;
constexpr size_t MiB = 1u << 20;
constexpr size_t WS_TCOS = 1 * MiB, WS_TSIN = 3 * MiB, WS_WPG = 5 * MiB, WS_WRET = 6 * MiB, WS_WPB = 14 * MiB, WS_WOUT = 18 * MiB,
    WS_SS = 26 * MiB, WS_PART = 30 * MiB, WS_PART2 = 32 * MiB,
    WS_WIN = 36 * MiB, WS_WFI = 36 * MiB,
    WS_Q = 88 * MiB, WS_OG = 88 * MiB, WS_ACT = 88 * MiB,
    WS_K = 152 * MiB, WS_O = 152 * MiB, WS_MERGED = 152 * MiB,
    WS_VT = 216 * MiB, WS_TMP = 216 * MiB,
    WS_KDT = 280 * MiB, WS_WFO = 280 * MiB,
    WS_SRG = 344 * MiB, WS_HB = 344 * MiB,
    WS_U = 408 * MiB, WS_PP = 408 * MiB, WS_PIN = 424 * MiB,
    WS_PZ = 472 * MiB, WS_P2 = 472 * MiB,
    WS_END = 504 * MiB;
constexpr int LDS_BYTES = 147456;
#ifndef PHASES
#define PHASES 0x3ff
#endif
#ifndef REPEAT
#define REPEAT 0x0
#endif

__device__ __forceinline__ u32x4 pack8(f32x4 a, f32x4 b) { u32x4 w; w.x = cvt_pk_bf16(a[0], a[1]); w.y = cvt_pk_bf16(a[2], a[3]); w.z = cvt_pk_bf16(b[0], b[1]); w.w = cvt_pk_bf16(b[2], b[3]); return w; }
__device__ __forceinline__ void unpack8(u32x4 w, f32x4& a, f32x4& b) {
    a[0] = __uint_as_float(w.x << 16); a[1] = __uint_as_float(w.x & 0xffff0000u); a[2] = __uint_as_float(w.y << 16); a[3] = __uint_as_float(w.y & 0xffff0000u);
    b[0] = __uint_as_float(w.z << 16); b[1] = __uint_as_float(w.z & 0xffff0000u); b[2] = __uint_as_float(w.w << 16); b[3] = __uint_as_float(w.w & 0xffff0000u); }
__device__ __forceinline__ unsigned short f2bf(float f) { unsigned u = __float_as_uint(f); return (unsigned short)((u + 0x7fffu + ((u >> 16) & 1u)) >> 16); }
__device__ __forceinline__ float sigmoidf_(float x) { return __builtin_amdgcn_rcpf(1.0f + __expf(-x)); }
__device__ __forceinline__ f32x4 sig4(f32x4 v) { f32x4 r; r[0] = sigmoidf_(v[0]); r[1] = sigmoidf_(v[1]); r[2] = sigmoidf_(v[2]); r[3] = sigmoidf_(v[3]); return r; }
__device__ __forceinline__ float dot4(f32x4 a) { return (a[0] * a[0] + a[1] * a[1]) + (a[2] * a[2] + a[3] * a[3]); }
__device__ __forceinline__ float sum4(f32x4 a) { return (a[0] + a[1]) + (a[2] + a[3]); }
__device__ __forceinline__ float wave_sum(float v) {
#pragma unroll
    for (int o = 1; o < 64; o <<= 1) v += __shfl_xor(v, o);
    return v;
}
__device__ __forceinline__ float head_lg2(int h) { return log2f(1.0f - exp2f(-5.0f - (float)h)); }

__device__ __forceinline__ unsigned dpp_xor1(unsigned v) { return (unsigned)__builtin_amdgcn_update_dpp(0, (int)v, 0xB1, 0xF, 0xF, true); }
__device__ __forceinline__ unsigned dpp_xor2(unsigned v) { return (unsigned)__builtin_amdgcn_update_dpp(0, (int)v, 0x4E, 0xF, 0xF, true); }
__device__ __forceinline__ void quad_transpose(unsigned& x0, unsigned& x1, unsigned& x2, unsigned& x3, int b) {
    const bool o1 = (b & 1) != 0, o2 = (b & 2) != 0;
    const unsigned r01 = dpp_xor1(o1 ? x0 : x1), r23 = dpp_xor1(o1 ? x2 : x3);
    if (o1) { x0 = r01; x2 = r23; } else { x1 = r01; x3 = r23; }
    const unsigned r02 = dpp_xor2(o2 ? x0 : x2), r13 = dpp_xor2(o2 ? x1 : x3);
    if (o2) { x0 = r02; x1 = r13; } else { x2 = r02; x3 = r13; }
}
__device__ __forceinline__ void tr_store(bf16* p, int second, f32x4 v0, f32x4 v1, int b) {
    unsigned x0 = cvt_pk_bf16(v0[0], v0[1]), x1 = cvt_pk_bf16(v0[2], v0[3]), x2 = cvt_pk_bf16(v1[0], v1[1]), x3 = cvt_pk_bf16(v1[2], v1[3]);
    quad_transpose(x0, x1, x2, x3, b);
    u32x2 lo, hi; lo.x = __builtin_amdgcn_perm(x1, x0, 0x05040100u); lo.y = __builtin_amdgcn_perm(x3, x2, 0x05040100u);
    hi.x = __builtin_amdgcn_perm(x1, x0, 0x07060302u); hi.y = __builtin_amdgcn_perm(x3, x2, 0x07060302u);
    *(u32x2*)p = lo; *(u32x2*)(p + second) = hi;
}

typedef const f32x4 (&AccRef)[2][2][4][2];

struct EpiProj {
    static constexpr bool PERM = true, AFTER_DRAIN = false;
    bf16 *q, *k, *kdT, *vT, *srg, *pz, *sg; const float *tcos, *tsin;
    __device__ __forceinline__ void operator()(AccRef acc, const pg8::Unit& u, int wr, int wc, int fr, int fq) const {
        const int pn = u.pn, row0 = u.pm * 256 + wr * 64 + fr, cl = wc * 32 + 8 * fq;
        if (pn < 16) {
            const bool isk = pn >= 8; const int h = pn & 7; bf16* dst = isk ? k : q;
            const float lg2 = head_lg2(h);
#pragma unroll
            for (int ai = 0; ai < 2; ++ai) {
                f32x4 tcv[4][2], tsv[4][2];
#pragma unroll
                for (int m = 0; m < 4; ++m) { const int pos_ = (row0 + ai * 128 + m * 16) & 4095; const float* tc = tcos + pos_ * 128 + cl; const float* ts = tsin + pos_ * 128 + cl;
                    tcv[m][0] = *(const f32x4*)tc; tcv[m][1] = *(const f32x4*)(tc + 4); tsv[m][0] = *(const f32x4*)ts; tsv[m][1] = *(const f32x4*)(ts + 4); }
#pragma unroll
                for (int m = 0; m < 4; ++m) {
                    int r = row0 + ai * 128 + m * 16; asm volatile("" : "+v"(r)); const int pos = r & 4095;
                    const f32x4 c0 = tcv[m][0], c1 = tcv[m][1], s0 = tsv[m][0], s1 = tsv[m][1];
                    const f32x4 a0 = acc[ai][0][m][0], a1 = acc[ai][0][m][1], b0 = acc[ai][1][m][0], b1 = acc[ai][1][m][1];
                    const f32x4 o10 = (a0 * c0 - b0 * s0) * 0.0625f, o11 = (a1 * c1 - b1 * s1) * 0.0625f;
                    const f32x4 o20 = (a0 * s0 + b0 * c0) * 0.0625f, o21 = (a1 * s1 + b1 * c1) * 0.0625f;
                    const size_t blk = ((size_t)(((r >> 12) * 8 + h) * 64 + (pos >> 6))) * 16384;
                    const int nn = r & 63;
                    bf16* rp = dst + blk + (size_t)(((((cl >> 5) * 2 + (nn >> 5)) * 2 + ((cl >> 4) & 1)) * 64 + ((cl >> 3) & 1) * 32 + (nn & 31)) * 8);
                    *(u32x4*)rp = pack8(o10, o11); *(u32x4*)(rp + 4 * 2048) = pack8(o20, o21);
                    if (isk) {
                        const float kd = exp2f((float)(63 - (r & 63)) * lg2);
                        const int dq = cl + 2 * (fr & 3), dl = dq & 31, sg2 = (dl & 0x13) | ((dl & 4) << 1) | ((dl & 8) >> 1);
                        bf16* tb = kdT + blk + (size_t)((((dq >> 5) * 4 + m) * 64 + ((fr >> 3) & 1) * 32 + sg2) * 8 + (fr & 4));
                        tr_store(tb, 8, o10 * kd, o11 * kd, fr & 3); tr_store(tb + 4 * 4 * 64 * 8, 8, o20 * kd, o21 * kd, fr & 3);
                    }
                }
                asm volatile("" ::: "memory");
            }
        } else if (pn < 24) {
            const int h = pn - 16;
#pragma unroll
            for (int ai = 0; ai < 2; ++ai)
#pragma unroll
                for (int m = 0; m < 4; ++m) {
                    int r = row0 + ai * 128 + m * 16; asm volatile("" : "+v"(r)); const int pos = r & 4095;
                    const int vq = cl + 2 * (fr & 3);
                    bf16* tb = vT + ((size_t)(((r >> 12) * 8 + h) * 64 + (pos >> 6))) * 16384 + (size_t)((((vq >> 5) * 4 + m) * 64 + ((fr >> 3) & 1) * 32 + (vq & 31)) * 8 + (fr & 4));
                    tr_store(tb, 8, acc[ai][0][m][0], acc[ai][0][m][1], fr & 3); tr_store(tb + 4 * 4 * 64 * 8, 8, acc[ai][1][m][0], acc[ai][1][m][1], fr & 3);
                }
        } else if (pn < 32) {
            const int c0 = (pn - 24) * 256 + cl;
#pragma unroll
            for (int ai = 0; ai < 2; ++ai)
#pragma unroll
                for (int m = 0; m < 4; ++m) { const int r = row0 + ai * 128 + m * 16;
#pragma unroll
                    for (int bj = 0; bj < 2; ++bj) { const f32x4 v0 = acc[ai][bj][m][0], v1 = acc[ai][bj][m][1];
                        *(u32x4*)(srg + (size_t)r * 2048 + c0 + bj * 128) = pack8(v0 * sig4(v0), v1 * sig4(v1)); } }
        } else if (pn < 36) {
            const int c0 = (pn - 32) * 256 + cl;
#pragma unroll
            for (int ai = 0; ai < 2; ++ai)
#pragma unroll
                for (int m = 0; m < 4; ++m) { const int r = row0 + ai * 128 + m * 16;
#pragma unroll
                    for (int bj = 0; bj < 2; ++bj) *(u32x4*)(pz + (size_t)r * 1024 + c0 + bj * 128) = pack8(acc[ai][bj][m][0], acc[ai][bj][m][1]); }
        } else {
            const int c0 = (pn - 36) * 256 + cl;
#pragma unroll
            for (int ai = 0; ai < 2; ++ai)
#pragma unroll
                for (int m = 0; m < 4; ++m) { const int r = row0 + ai * 128 + m * 16;
#pragma unroll
                    for (int bj = 0; bj < 2; ++bj) *(u32x4*)(sg + (size_t)r * 4096 + c0 + bj * 128) = pack8(sig4(acc[ai][bj][m][0]), sig4(acc[ai][bj][m][1])); }
        }
    }
};

struct EpiPlain {
    static constexpr bool PERM = true, AFTER_DRAIN = false;
    bf16* O; int ldc;
    __device__ __forceinline__ void operator()(AccRef acc, const pg8::Unit& u, int wr, int wc, int fr, int fq) const {
        const int row0 = u.pm * 256 + wr * 64 + fr, c0 = u.pn * 256 + wc * 32 + 8 * fq;
#pragma unroll
        for (int ai = 0; ai < 2; ++ai)
#pragma unroll
            for (int m = 0; m < 4; ++m) { const int r = row0 + ai * 128 + m * 16;
#pragma unroll
                for (int bj = 0; bj < 2; ++bj) *(u32x4*)(O + (size_t)r * ldc + c0 + bj * 128) = pack8(acc[ai][bj][m][0], acc[ai][bj][m][1]); }
    }
};

template <bool SECOND> struct EpiGate {
    static constexpr bool PERM = true, AFTER_DRAIN = false;
    const bf16* sg; bf16* tmp; bf16* merged;
    __device__ __forceinline__ void operator()(AccRef acc, const pg8::Unit& u, int wr, int wc, int fr, int fq) const {
        const int row0 = u.pm * 256 + wr * 64 + fr, c0 = u.pn * 256 + wc * 32 + 8 * fq;
#pragma unroll
        for (int ai = 0; ai < 2; ++ai) {
            u32x4 gv[4][2], tv[4][2];
#pragma unroll
            for (int m = 0; m < 4; ++m) { const int r = row0 + ai * 128 + m * 16;
#pragma unroll
                for (int bj = 0; bj < 2; ++bj) { const int c = c0 + bj * 128;
                    gv[m][bj] = *(const u32x4*)(sg + (size_t)r * 4096 + (SECOND ? 0 : 2048) + c);
                    if (SECOND) tv[m][bj] = *(const u32x4*)(tmp + (size_t)r * 2048 + c); } }
#pragma unroll
            for (int m = 0; m < 4; ++m) { const int r = row0 + ai * 128 + m * 16;
#pragma unroll
                for (int bj = 0; bj < 2; ++bj) { const int c = c0 + bj * 128;
                    f32x4 g0, g1; unpack8(gv[m][bj], g0, g1);
                    f32x4 v0 = g0 * acc[ai][bj][m][0], v1 = g1 * acc[ai][bj][m][1];
                    if (SECOND) { f32x4 t0, t1; unpack8(tv[m][bj], t0, t1); v0 += t0; v1 += t1;
                        *(u32x4*)(merged + (size_t)r * 2048 + c) = pack8(v0, v1); }
                    else *(u32x4*)(tmp + (size_t)r * 2048 + c) = pack8(v0, v1); } }
            asm volatile("" ::: "memory"); }
    }
};

template <bool FIRST> struct EpiRes {
    static constexpr bool PERM = true, AFTER_DRAIN = false;
    const float* x; bf16* hb; float* hout; float* part;
    __device__ __forceinline__ void operator()(AccRef acc, const pg8::Unit& u, int wr, int wc, int fr, int fq) const {
        const int row0 = u.pm * 256 + wr * 64 + fr, c0 = u.pn * 256 + wc * 32 + 8 * fq;
#pragma unroll
        for (int ai = 0; ai < 2; ++ai) {
            f32x4 xv[4][2][2]; u32x4 hv[4][2];
#pragma unroll
            for (int m = 0; m < 4; ++m) { const int r = row0 + ai * 128 + m * 16;
#pragma unroll
                for (int bj = 0; bj < 2; ++bj) { const size_t off = (size_t)r * 2048 + c0 + bj * 128;
                    if (FIRST) { xv[m][bj][0] = *(const f32x4*)(x + off); xv[m][bj][1] = *(const f32x4*)(x + off + 4); } else hv[m][bj] = *(const u32x4*)(hb + off); } }
#pragma unroll
            for (int m = 0; m < 4; ++m) { const int r = row0 + ai * 128 + m * 16; float s = 0.f;
#pragma unroll
                for (int bj = 0; bj < 2; ++bj) { const size_t off = (size_t)r * 2048 + c0 + bj * 128;
                    f32x4 h0, h1;
                    if (FIRST) { h0 = xv[m][bj][0] + acc[ai][bj][m][0]; h1 = xv[m][bj][1] + acc[ai][bj][m][1]; }
                    else { unpack8(hv[m][bj], h0, h1); h0 += acc[ai][bj][m][0]; h1 += acc[ai][bj][m][1]; }
                    *(u32x4*)(hb + off) = pack8(h0, h1);
                    s += dot4(h0) + dot4(h1); }
                s += __shfl_xor(s, 16); s += __shfl_xor(s, 32);
                if (fq == 0) part[(size_t)r * 32 + u.pn * 4 + wc] = s; }
            asm volatile("" ::: "memory"); }
    }
};

struct EpiSwiglu {
    static constexpr bool PERM = true, AFTER_DRAIN = false;
    const float* part; bf16* act;
    __device__ __forceinline__ void operator()(AccRef acc, const pg8::Unit& u, int wr, int wc, int fr, int fq) const {
        const int row0 = u.pm * 256 + wr * 64 + fr, c0 = u.pn * 128 + wc * 32 + 8 * fq;
        float r2[2][4];
#pragma unroll
        for (int ai = 0; ai < 2; ++ai)
#pragma unroll
            for (int m = 0; m < 4; ++m) { const int r = row0 + ai * 128 + m * 16;
                const float* pp = part + (size_t)r * 32 + 8 * fq;
                float s = sum4(*(const f32x4*)pp) + sum4(*(const f32x4*)(pp + 4));
                s += __shfl_xor(s, 16); s += __shfl_xor(s, 32);
                r2[ai][m] = 1.0f / sqrtf(s * (1.0f / 2048.0f) + EPS); }
#pragma unroll
        for (int ai = 0; ai < 2; ++ai)
#pragma unroll
            for (int m = 0; m < 4; ++m) { const int r = row0 + ai * 128 + m * 16; const float rr = r2[ai][m];
                const f32x4 a0 = acc[ai][0][m][0] * rr, a1 = acc[ai][0][m][1] * rr, b0 = acc[ai][1][m][0] * rr, b1 = acc[ai][1][m][1] * rr;
                *(u32x4*)(act + (size_t)r * DFF + c0) = pack8(a0 * sig4(a0) * b0, a1 * sig4(a1) * b1); }
    }
};

__device__ __forceinline__ void conv_matrix(const float* W, int K, int N, bf16* WT, const float* sk, const float* sn, int mode, LAS float* scr, int lane, int gw, int NGW) {
    const int nblk = N / 32, nitems = (K / 64) * nblk;
    float v[32];
    int it = gw;
    if (it < nitems) { const int kb = it / nblk, nb = it - kb * nblk; const float* src = W + (size_t)(64 * kb + (lane >> 5)) * N + 32 * nb + (lane & 31);
#pragma unroll
        for (int i = 0; i < 32; ++i) v[i] = src[(size_t)(2 * i) * N]; }
    for (; it < nitems; it += NGW) {
        const int kb = it / nblk, nb = it - kb * nblk, n0 = 32 * nb, k0 = 64 * kb; int drow0 = n0;
        if (mode == 1) drow0 = n0 < DFF ? 256 * (n0 >> 7) + (n0 & 127) : 256 * ((n0 - DFF) >> 7) + 128 + ((n0 - DFF) & 127);
#pragma unroll
        for (int i = 0; i < 32; ++i) { const int kk = 2 * i + (lane >> 5); float t = v[i]; if (sk) t *= sk[k0 + kk]; scr[kk * 33 + (lane & 31)] = t; }
        const int nx = it + NGW;
        if (nx < nitems) { const int kb2 = nx / nblk, nb2 = nx - kb2 * nblk; const float* src = W + (size_t)(64 * kb2 + (lane >> 5)) * N + 32 * nb2 + (lane & 31);
#pragma unroll
            for (int i = 0; i < 32; ++i) v[i] = src[(size_t)(2 * i) * N]; }
        LDS_WAIT(); asm volatile("" ::: "memory");
        const int c = lane & 7;
#pragma unroll
        for (int j = 0; j < 4; ++j) { const int n = (lane >> 3) + 8 * j; const LAS float* sp = scr + (8 * c) * 33 + n; const float mn = sn ? sn[n0 + n] : 1.0f;
            u32x4 o; o.x = cvt_pk_bf16(sp[0 * 33] * mn, sp[1 * 33] * mn); o.y = cvt_pk_bf16(sp[2 * 33] * mn, sp[3 * 33] * mn); o.z = cvt_pk_bf16(sp[4 * 33] * mn, sp[5 * 33] * mn); o.w = cvt_pk_bf16(sp[6 * 33] * mn, sp[7 * 33] * mn);
            *(u32x4*)(WT + (size_t)(drow0 + n) * K + k0 + 8 * c) = o; }
        LDS_WAIT(); asm volatile("" ::: "memory");
    }
}

__device__ __forceinline__ void scores_phase(const bf16* q, const bf16* k, bf16* Pp, int bid, int G, int wave, int lane) {
    const int g = lane >> 4, l16 = lane & 15, nt = wave >> 1, mt0 = 2 * (wave & 1);
    const int n = 16 * nt + l16, ma = 16 * mt0 + l16, mb = ma + 16;
    const int qo = (((n >> 5) * 2 + (g >> 1)) * 64 + (g & 1) * 32 + (n & 31)) * 8, kao = (((ma >> 5) * 2 + (g >> 1)) * 64 + (g & 1) * 32 + (ma & 31)) * 8, kbo = (((mb >> 5) * 2 + (g >> 1)) * 64 + (g & 1) * 32 + (mb & 31)) * 8;
    bf16x8 nqa[8], nka[8], nkb[8];
    if (bid < 2048) {
#pragma unroll
        for (int s = 0; s < 8; ++s) { nqa[s] = *(const bf16x8*)(q + (size_t)bid * 16384 + qo + 2048 * s); nka[s] = *(const bf16x8*)(k + (size_t)bid * 16384 + kao + 2048 * s); nkb[s] = *(const bf16x8*)(k + (size_t)bid * 16384 + kbo + 2048 * s); } }
    for (int unit = bid; unit < 2048; unit += G) {
        const int bh = unit >> 6, h = bh & 7;
        const float lg2 = head_lg2(h);
        bf16x8 qa[8], ka[8], kb[8];
#pragma unroll
        for (int s = 0; s < 8; ++s) { qa[s] = nqa[s]; ka[s] = nka[s]; kb[s] = nkb[s]; }
        if (unit + G < 2048) { const size_t ub = (size_t)(unit + G) * 16384;
#pragma unroll
            for (int s = 0; s < 8; ++s) { nqa[s] = *(const bf16x8*)(q + ub + qo + 2048 * s); nka[s] = *(const bf16x8*)(k + ub + kao + 2048 * s); nkb[s] = *(const bf16x8*)(k + ub + kbo + 2048 * s); } }
        f32x4 c0 = {0.f, 0.f, 0.f, 0.f}, c1 = {0.f, 0.f, 0.f, 0.f};
#pragma unroll
        for (int s = 0; s < 8; ++s) { c0 = __builtin_amdgcn_mfma_f32_16x16x32_bf16(ka[s], qa[s], c0, 0, 0, 0); c1 = __builtin_amdgcn_mfma_f32_16x16x32_bf16(kb[s], qa[s], c1, 0, 0, 0); }
#pragma unroll
        for (int j = 0; j < 2; ++j) { const f32x4 c = j ? c1 : c0; const int m0 = 16 * (mt0 + j) + 4 * g; float o[4];
#pragma unroll
            for (int i = 0; i < 4; ++i) { const int mm = m0 + i, e = (n > mm ? n - mm : mm - n) - n - 1; o[i] = c[i] * exp2f((float)e * lg2); }
            u32x2 w; w.x = cvt_pk_bf16(o[0], o[1]); w.y = cvt_pk_bf16(o[2], o[3]);
            *(u32x2*)(Pp + (size_t)unit * 4096 + (((n >> 5) * 4 + (m0 >> 4)) * 64 + ((m0 >> 3) & 1) * 32 + (n & 31)) * 8 + (m0 & 7)) = w; }
    }
}

template <int W> __device__ __forceinline__ void pool_item(const bf16* pz, bf16* pin, int t0, int s0, int c8) {
    constexpr int R = 8 + W - 1;
    u32x4 raw[R];
#pragma unroll
    for (int j = 0; j < R; ++j) { const int dj = j - (W - 1); const bool ok = (s0 + dj) >= 0;
        raw[j] = *(const u32x4*)(pz + (size_t)(t0 + (ok ? dj : 0)) * DPOOL + c8 * 8); if (!ok) raw[j] = (u32x4){0u, 0u, 0u, 0u}; }
    u32x4 outw[8];
#pragma unroll
    for (int d = 0; d < 4; ++d) {
        float lo[R], hi[R], slo[8], shi[8];
#pragma unroll
        for (int j = 0; j < R; ++j) { lo[j] = __uint_as_float(raw[j][d] << 16); hi[j] = __uint_as_float(raw[j][d] & 0xffff0000u); }
#pragma unroll
        for (int i = 0; i < 8; ++i) { slo[i] = lo[i + W - 1]; shi[i] = hi[i + W - 1]; }
#pragma unroll
        for (int st = 1; st < W; st *= 2)
#pragma unroll
            for (int j = 0; j + st < R; ++j) { lo[j] += lo[j + st]; hi[j] += hi[j + st]; }
#pragma unroll
        for (int i = 0; i < 8; ++i) { const int cn = (s0 + i + 1) < W ? (s0 + i + 1) : W; const float fc = (float)cn;
            outw[i][d] = cvt_pk_bf16(lo[i] / fc - slo[i], hi[i] / fc - shi[i]); }
    }
#pragma unroll
    for (int i = 0; i < 8; ++i) *(u32x4*)(pin + (size_t)(t0 + i) * DPOOL + c8 * 8) = outw[i];
}
__device__ __forceinline__ void pool_phase(const bf16* pz, bf16* pin, int gw, int NGW, int lane) {
    for (int wi = gw; wi < 4096; wi += NGW) {
        const int g = wi & 3, tb = (wi >> 2) * 2 + (lane >> 5), c8 = g * 32 + (lane & 31), t0 = tb * 8, s0 = t0 & (SEQ - 1);
        if (g == 0) pool_item<2>(pz, pin, t0, s0, c8); else if (g == 1) pool_item<4>(pz, pin, t0, s0, c8); else if (g == 2) pool_item<8>(pz, pin, t0, s0, c8); else pool_item<16>(pz, pin, t0, s0, c8);
    }
}

__device__ __forceinline__ bf16x8 pack_acc8(const f32x16& S, int s) {
    u32x4 w; w.x = cvt_pk_bf16(S[8 * s + 0], S[8 * s + 1]); w.y = cvt_pk_bf16(S[8 * s + 2], S[8 * s + 3]); w.z = cvt_pk_bf16(S[8 * s + 4], S[8 * s + 5]); w.w = cvt_pk_bf16(S[8 * s + 6], S[8 * s + 7]);
    return __builtin_bit_cast(bf16x8, w);
}
__device__ __forceinline__ void scan_phase(const bf16* q, const bf16* kdT, const bf16* vT, const bf16* Pp, bf16* o, LAS unsigned char* lds, int bid, int G, int wave, int lane, int tid) {
    const int rnt = tid >> 8, rj = (tid >> 6) & 3, rhh = (tid >> 5) & 1, rv = tid & 31, rn0 = 32 * rnt + 8 * rj + 4 * rhh;
    for (int unit = bid; unit < 256; unit += G) {
        const int bh = (unit & 7) * 4 + (unit >> 6), vs = (unit >> 3) & 7, b = bh >> 3, h = bh & 7;
        const float lg2 = head_lg2(h), cd = exp2f(64.0f * lg2);
        float qd[4];
#pragma unroll
        for (int e = 0; e < 4; ++e) qd[e] = exp2f((float)(rn0 + e + 1) * lg2);
        const char* kp = (const char*)kdT + ((size_t)bh * 64 * 16384 + wave * 2048) * 2;
        const char* vp = (const char*)vT + ((size_t)bh * 64 * 16384 + vs * 2048) * 2;
        const char* qp = (const char*)q + ((size_t)bh * 64 * 16384 + wave * 2048) * 2;
        const char* pp = (const char*)Pp + ((size_t)bh * 64 * 4096 + wave * 512) * 2;
        const unsigned voff = (unsigned)lane * 16u;
        bf16* op = o + (size_t)(b * SEQ + rn0) * 2048 + h * 256 + 32 * vs + rv;
        const int iks = wave & 3, int_ = wave >> 2;
        const int rboff = ((rnt * 2 + (rj >> 1)) * 64 + rhh * 32 + rv) * 16 + (rj & 1) * 8;
        f32x16 S;
#pragma unroll
        for (int e = 0; e < 16; ++e) S[e] = 0.f;
        bf16x8 kf[2][4], vf[4], vst, qf[3][2][2], pf[3];
#define SCAN_LOADV(VSET, CH) do { const size_t c_ = (size_t)(CH); \
            _Pragma("unroll") for (int s = 0; s < 4; ++s) kf[VSET][s] = *(const bf16x8*)(kp + c_ * 32768 + 1024 * s + voff); } while (0)
#define SCAN_LOAD(SET, CH) do { const size_t c_ = (size_t)(CH); \
            _Pragma("unroll") for (int nt = 0; nt < 2; ++nt) _Pragma("unroll") for (int s = 0; s < 2; ++s) qf[SET][nt][s] = *(const bf16x8*)(qp + c_ * 32768 + nt * 2048 + 1024 * s + voff); \
            pf[SET] = *(const bf16x8*)(pp + c_ * 8192 + voff); } while (0)
#define SCAN_STEP(CS, NS, VC, VN, I) do { const int i_ = (I); const int in_ = i_ + 2 < 64 ? i_ + 2 : 63, iv_ = i_ + 1 < 64 ? i_ + 1 : 63; \
            if (wave < 4) { *(LAS bf16x8*)(lds + 65536 + ((i_ + 1) & 1) * 4096 + wave * 1024 + voff) = vst; vst = *(const bf16x8*)(vp + (size_t)in_ * 32768 + 1024 * wave + voff); } \
            SCAN_LOAD(NS, in_); SCAN_LOADV(VN, iv_); \
            const bf16x8 Bf0 = pack_acc8(S, 0), Bf1 = pack_acc8(S, 1); \
            LAS u32x4* pb = (LAS u32x4*)(lds + (i_ & 1) * 32768 + wave * 4096); \
            _Pragma("unroll") for (int nt = 0; nt < 2; ++nt) { f32x16 p; \
                _Pragma("unroll") for (int e = 0; e < 16; ++e) p[e] = 0.f; \
                p = __builtin_amdgcn_mfma_f32_32x32x16_bf16(qf[CS][nt][0], Bf0, p, 0, 0, 0); p = __builtin_amdgcn_mfma_f32_32x32x16_bf16(qf[CS][nt][1], Bf1, p, 0, 0, 0); \
                if (int_ == nt) { if (iks == 0) p = __builtin_amdgcn_mfma_f32_32x32x16_bf16(pf[CS], vf[0], p, 0, 0, 0); else if (iks == 1) p = __builtin_amdgcn_mfma_f32_32x32x16_bf16(pf[CS], vf[1], p, 0, 0, 0); \
                    else if (iks == 2) p = __builtin_amdgcn_mfma_f32_32x32x16_bf16(pf[CS], vf[2], p, 0, 0, 0); else p = __builtin_amdgcn_mfma_f32_32x32x16_bf16(pf[CS], vf[3], p, 0, 0, 0); } \
                _Pragma("unroll") for (int jp = 0; jp < 2; ++jp) { u32x4 w_; w_.x = cvt_pk_bf16(p[8 * jp], p[8 * jp + 1]); w_.y = cvt_pk_bf16(p[8 * jp + 2], p[8 * jp + 3]); \
                    w_.z = cvt_pk_bf16(p[8 * jp + 4], p[8 * jp + 5]); w_.w = cvt_pk_bf16(p[8 * jp + 6], p[8 * jp + 7]); pb[(2 * nt + jp) * 64 + lane] = w_; } } \
            S = S * cd; \
            _Pragma("unroll") for (int s = 0; s < 4; ++s) S = __builtin_amdgcn_mfma_f32_32x32x16_bf16(kf[VC][s], vf[s], S, 0, 0, 0); \
            LDS_WAIT(); __builtin_amdgcn_s_barrier(); asm volatile("" ::: "memory"); \
            const LAS u32x2* rb = (const LAS u32x2*)(lds + (i_ & 1) * 32768 + rboff); \
            f32x4 a = {0.f, 0.f, 0.f, 0.f}; \
            _Pragma("unroll") for (int w = 0; w < 8; ++w) { const u32x2 x_ = rb[w * 512]; \
                a[0] += __uint_as_float(x_.x << 16); a[1] += __uint_as_float(x_.x & 0xffff0000u); a[2] += __uint_as_float(x_.y << 16); a[3] += __uint_as_float(x_.y & 0xffff0000u); } \
            _Pragma("unroll") for (int e = 0; e < 4; ++e) op[(size_t)i_ * 64 * 2048 + (size_t)e * 2048] = f2bf(a[e] * qd[e]); \
            _Pragma("unroll") for (int s = 0; s < 4; ++s) vf[s] = *(const LAS bf16x8*)(lds + 65536 + ((i_ + 1) & 1) * 4096 + s * 1024 + voff); \
            __builtin_amdgcn_sched_barrier(0); \
        } while (0)
        SCAN_LOAD(0, 0); SCAN_LOAD(1, 1); SCAN_LOADV(0, 0);
        vst = *(const bf16x8*)(vp + 1024 * (wave & 3) + voff);
        if (wave < 4) { *(LAS bf16x8*)(lds + 65536 + wave * 1024 + voff) = vst; vst = *(const bf16x8*)(vp + (size_t)32768 + 1024 * wave + voff); }
        LDS_WAIT(); __builtin_amdgcn_s_barrier(); asm volatile("" ::: "memory");
#pragma unroll
        for (int s = 0; s < 4; ++s) vf[s] = *(const LAS bf16x8*)(lds + 65536 + s * 1024 + voff);
        for (int i = 0; i < 60; i += 6) { SCAN_STEP(0, 2, 0, 1, i); SCAN_STEP(1, 0, 1, 0, i + 1); SCAN_STEP(2, 1, 0, 1, i + 2); SCAN_STEP(0, 2, 1, 0, i + 3); SCAN_STEP(1, 0, 0, 1, i + 4); SCAN_STEP(2, 1, 1, 0, i + 5); }
        SCAN_STEP(0, 2, 0, 1, 60); SCAN_STEP(1, 0, 1, 0, 61); SCAN_STEP(2, 1, 0, 1, 62); SCAN_STEP(0, 2, 1, 0, 63);
#undef SCAN_LOADV
#undef SCAN_STEP
#undef SCAN_LOAD
        __syncthreads();
    }
}

#define XB_TMO      128
#define XB_XCNT(j)  (256  + 64 * (j))
#define XB_XSUB(j)  (1280 + 64 * (j))
#define XB_XGEN(j)  (2304 + 64 * (j))
#define XB_TOP      3328
#define XB_TOPGEN   3392
#define XCD_BAR_WORDS 3456
#define XB_SPIN_CAP (1u << 18)

__device__ __forceinline__ unsigned xb_ld(unsigned* p)              { return __hip_atomic_load(p, __ATOMIC_RELAXED, __HIP_MEMORY_SCOPE_AGENT); }
__device__ __forceinline__ unsigned xb_add(unsigned* p, unsigned v) { return __hip_atomic_fetch_add(p, v, __ATOMIC_RELAXED, __HIP_MEMORY_SCOPE_AGENT); }
__device__ __forceinline__ unsigned xb_xcc_id() { return (unsigned)__builtin_amdgcn_s_getreg((3 << 11) | 20) & 0xFu; }
#define XB_SPIN(cond, bar) do { unsigned _sp = 0; while (cond) { __builtin_amdgcn_s_sleep(1); \
    if ((++_sp & 255u) == 0u) { if (xb_ld(&(bar)[XB_TMO])) break; if (_sp > XB_SPIN_CAP) { atomicAdd(&(bar)[XB_TMO], 1u); break; } } } } while (0)

struct XcdBarrier {
    unsigned* bar; unsigned x;
    volatile LAS unsigned* st;
};

__device__ __forceinline__ XcdBarrier xcd_barrier_post(unsigned* bar, volatile LAS unsigned* st) {
    XcdBarrier b; b.bar = bar; b.x = xb_xcc_id(); b.st = st;
    if (threadIdx.x == 0) (void)xb_add(&bar[XB_XCNT(b.x)], 1u);
    return b;
}
__device__ __forceinline__ void xcd_barrier_complete(unsigned* bar, unsigned x, unsigned& nloc, unsigned& nx) {
    const unsigned G = gridDim.x * gridDim.y * gridDim.z;
    unsigned sum, cnt, mine, sp = 0u;
    for (;;) {
        sum = 0u; cnt = 0u; mine = 0u;
#pragma unroll
        for (unsigned j = 0; j < 16; ++j) { const unsigned c = xb_ld(&bar[XB_XCNT(j)]); sum += c; cnt += (c > 0u) ? 1u : 0u; mine = (j == x) ? c : mine; }
        if (sum == G) break;
        __builtin_amdgcn_s_sleep(1);
        if ((++sp & 255u) == 0u) { if (xb_ld(&bar[XB_TMO])) break; if (sp > XB_SPIN_CAP) { atomicAdd(&bar[XB_TMO], 1u); break; } }
    }
    nloc = mine > 0u ? mine : 1u; nx = cnt > 0u ? cnt : 1u;
}

__device__ __forceinline__ void xcd_barrier(const XcdBarrier& b) {
    asm volatile("s_waitcnt vmcnt(0)" ::: "memory");
    __syncthreads();
    if (threadIdx.x == 0) {
        unsigned* bar = b.bar;
        __builtin_amdgcn_s_waitcnt(0);
        unsigned nloc = b.st[0], nx = b.st[1];
        if (nloc == 0u) { xcd_barrier_complete(bar, b.x, nloc, nx); b.st[0] = nloc; b.st[1] = nx; }
        const unsigned old = xb_add(&bar[XB_XSUB(b.x)], 1u);
        const unsigned gen = old / nloc;
        if (old + 1u == (gen + 1u) * nloc) {
            __builtin_amdgcn_fence(__ATOMIC_RELEASE, "agent");
            asm volatile("s_waitcnt vmcnt(0)" ::: "memory");
            const unsigned og = xb_add(&bar[XB_TOP], 1u);
            const unsigned tg = og / nx;
            if (og + 1u == (tg + 1u) * nx) xb_add(&bar[XB_TOPGEN], 1u);
            else XB_SPIN(xb_ld(&bar[XB_TOPGEN]) == tg, bar);
            __builtin_amdgcn_fence(__ATOMIC_ACQUIRE, "agent");
            xb_add(&bar[XB_XGEN(b.x)], 1u);
            asm volatile("s_waitcnt vmcnt(0)" ::: "memory");
        } else {
            XB_SPIN(xb_ld(&bar[XB_XGEN(b.x)]) == gen, bar);
            __builtin_amdgcn_fence(__ATOMIC_ACQUIRE, "agent");
            asm volatile("s_waitcnt vmcnt(0)" ::: "memory");
        }
    }
    __syncthreads();
}

struct Args { const float* in[12]; float* out; unsigned char* ws; };

__global__ void __launch_bounds__(512, 2) fwd_megakernel(Args a) {
    extern __shared__ __attribute__((aligned(16))) unsigned char lds_raw[];
    { LAS unsigned* lc = (LAS unsigned*)((LAS unsigned char*)lds_raw + 131072); if (threadIdx.x < 128) lc[threadIdx.x] = 0u; }
    __syncthreads();
    XcdBarrier xbar = xcd_barrier_post((unsigned*)a.ws, (volatile LAS unsigned*)((LAS unsigned char*)lds_raw + 131072 + 64));
#define PH_IDS int tid = threadIdx.x; asm volatile("" : "+v"(tid)); const int lane = tid & 63, wave = __builtin_amdgcn_readfirstlane(tid >> 6); \
    const int bid = blockIdx.x, G = gridDim.x, gw = bid * 8 + wave, NGW = G * 8, gtid = bid * 512 + tid, gthreads = G * 512; \
    GAS unsigned char* wsg_ = (GAS unsigned char*)a.ws; asm volatile("" : "+s"(wsg_)); unsigned char* ws = (unsigned char*)wsg_; LAS unsigned char* lds = (LAS unsigned char*)lds_raw; LAS float* scr = (LAS float*)(lds + wave * 16384); \
    (void)lane; (void)gw; (void)NGW; (void)gtid; (void)gthreads; (void)scr; (void)ws; (void)G; (void)bid;

    if constexpr ((PHASES >> 0) & 1) for (int rep_ = 0; rep_ <= ((REPEAT >> 0) & 1); ++rep_) { PH_IDS
        conv_matrix(a.in[2], D, NPROJ, (bf16*)(ws + WS_WIN), a.in[1], nullptr, 0, scr, lane, gw, NGW);
        conv_matrix(a.in[3], D, D, (bf16*)(ws + WS_WRET), nullptr, nullptr, 0, scr, lane, gw, NGW);
        for (int g = 0; g < 4; ++g) conv_matrix(a.in[4] + (size_t)g * 65536, 256, 256, (bf16*)(ws + WS_WPG) + (size_t)g * 65536, nullptr, a.in[5] + 256 * g, 0, scr, lane, (gw + 32 * (g + 1)) % NGW, NGW);
        conv_matrix(a.in[6], DPOOL, D, (bf16*)(ws + WS_WPB), nullptr, nullptr, 0, scr, lane, (gw + NGW / 2) % NGW, NGW);
        conv_matrix(a.in[7], D, D, (bf16*)(ws + WS_WOUT), nullptr, nullptr, 0, scr, lane, gw, NGW);
        float* tcos = (float*)(ws + WS_TCOS); float* tsin = (float*)(ws + WS_TSIN);
        for (int idx = gtid; idx < SEQ * 128; idx += gthreads) {
            const int pos = idx >> 7, d = idx & 127;
            const float invf = 1.0f / powf(10000.0f, (float)(2 * d) * (1.0f / 256.0f));
            const float ang = (float)pos * invf;
            const double rev = (double)ang * 0.15915494309189535; const double fr = rev - rint(rev);
            const float rr = (float)(fr * 6.283185307179586);
            tcos[idx] = cosf(rr); tsin[idx] = sinf(rr);
        }
        const float* x = a.in[0]; bf16* ub = (bf16*)(ws + WS_U);
        f32x4 nv[8];
        if (gw < M) { const f32x4* xr = (const f32x4*)(x + (size_t)gw * D) + lane;
#pragma unroll
            for (int j = 0; j < 8; ++j) nv[j] = xr[64 * j]; }
        for (int m = gw; m < M; m += NGW) {
            f32x4 v[8]; float s = 0.f;
#pragma unroll
            for (int j = 0; j < 8; ++j) { v[j] = nv[j]; s += dot4(v[j]); }
            if (m + NGW < M) { const f32x4* xr = (const f32x4*)(x + (size_t)(m + NGW) * D) + lane;
#pragma unroll
                for (int j = 0; j < 8; ++j) nv[j] = xr[64 * j]; }
            const float rn = 1.0f / sqrtf(wave_sum(s) * (1.0f / 2048.0f) + EPS);
            u32x2* o8 = (u32x2*)(ub + (size_t)m * D) + lane;
#pragma unroll
            for (int j = 0; j < 8; ++j) { u32x2 w; w.x = cvt_pk_bf16(v[j][0] * rn, v[j][1] * rn); w.y = cvt_pk_bf16(v[j][2] * rn, v[j][3] * rn); o8[64 * j] = w; }
        }
    }
    xcd_barrier(xbar);

    if constexpr ((PHASES >> 1) & 1) for (int rep_ = 0; rep_ <= ((REPEAT >> 1) & 1); ++rep_) { PH_IDS
        pg8::Gemm g{(const bf16*)(ws + WS_U), (const bf16*)(ws + WS_WIN), D, D, D, 0}; pg8::StaticOrder S; S.init(M, NPROJ, G, bid);
        EpiProj E{(bf16*)(ws + WS_Q), (bf16*)(ws + WS_K), (bf16*)(ws + WS_KDT), (bf16*)(ws + WS_VT), (bf16*)(ws + WS_SRG), (bf16*)(ws + WS_PZ), (bf16*)a.out, (const float*)(ws + WS_TCOS), (const float*)(ws + WS_TSIN)};
        pg8::gemm_phase<EpiProj, pg8::StaticOrder, true, true>(lds, g, S, E);
    }
    xcd_barrier(xbar);

    if constexpr ((PHASES >> 2) & 1) for (int rep_ = 0; rep_ <= ((REPEAT >> 2) & 1); ++rep_) { PH_IDS
        scores_phase((const bf16*)(ws + WS_Q), (const bf16*)(ws + WS_K), (bf16*)(ws + WS_PP), bid, G, wave, lane);
        pool_phase((const bf16*)(ws + WS_PZ), (bf16*)(ws + WS_PIN), gw, NGW, lane);
        conv_matrix(a.in[9], D, 2 * DFF, (bf16*)(ws + WS_WFI), a.in[8], nullptr, 1, scr, lane, gw, NGW);
    }
    xcd_barrier(xbar);

    if constexpr ((PHASES >> 3) & 1) for (int rep_ = 0; rep_ <= ((REPEAT >> 3) & 1); ++rep_) { PH_IDS
        scan_phase((const bf16*)(ws + WS_Q), (const bf16*)(ws + WS_KDT), (const bf16*)(ws + WS_VT), (const bf16*)(ws + WS_PP), (bf16*)(ws + WS_O), lds, bid, G, wave, lane, tid);
    }
    xcd_barrier(xbar);

    if constexpr ((PHASES >> 4) & 1) for (int rep_ = 0; rep_ <= ((REPEAT >> 4) & 1); ++rep_) { PH_IDS
        { pg8::Gemm g{(const bf16*)(ws + WS_PIN), (const bf16*)(ws + WS_WPG), DPOOL, 256, 256, 256}; pg8::StaticOrder S; S.init(M, DPOOL, G, bid);
          EpiPlain E{(bf16*)(ws + WS_P2), DPOOL};
          pg8::gemm_phase<EpiPlain, pg8::StaticOrder, true, true>(lds, g, S, E); }
        const bf16* ob = (const bf16*)(ws + WS_O); const bf16* srg = (const bf16*)(ws + WS_SRG); bf16* og = (bf16*)(ws + WS_OG);
        u32x4 nob[4], nsr[4];
        if (gw < M) {
#pragma unroll
            for (int jj = 0; jj < 4; ++jj) { const int c = jj * 512 + lane * 8; nob[jj] = *(const u32x4*)(ob + (size_t)gw * 2048 + c); nsr[jj] = *(const u32x4*)(srg + (size_t)gw * 2048 + c); } }
        for (int r = gw; r < M; r += NGW) {
            u32x4 cob[4], csr[4];
#pragma unroll
            for (int jj = 0; jj < 4; ++jj) { cob[jj] = nob[jj]; csr[jj] = nsr[jj]; }
            if (r + NGW < M) {
#pragma unroll
                for (int jj = 0; jj < 4; ++jj) { const int c = jj * 512 + lane * 8; nob[jj] = *(const u32x4*)(ob + (size_t)(r + NGW) * 2048 + c); nsr[jj] = *(const u32x4*)(srg + (size_t)(r + NGW) * 2048 + c); } }
#pragma unroll
            for (int jj = 0; jj < 4; ++jj) { const int c = jj * 512 + lane * 8;
                f32x4 o0, o1, s0, s1; unpack8(cob[jj], o0, o1); unpack8(csr[jj], s0, s1);
                float tot = dot4(o0) + dot4(o1);
                tot += __shfl_xor(tot, 1); tot += __shfl_xor(tot, 2); tot += __shfl_xor(tot, 4); tot += __shfl_xor(tot, 8); tot += __shfl_xor(tot, 16);
                const float rn = 1.0f / sqrtf(tot * (1.0f / 256.0f) + EPS);
                *(u32x4*)(og + (size_t)r * 2048 + c) = pack8(o0 * rn * s0, o1 * rn * s1); }
        }
        conv_matrix(a.in[10], DFF, D, (bf16*)(ws + WS_WFO), nullptr, nullptr, 0, scr, lane, gw, NGW);
    }
    xcd_barrier(xbar);

    if constexpr ((PHASES >> 5) & 1) for (int rep_ = 0; rep_ <= ((REPEAT >> 5) & 1); ++rep_) {
        { PH_IDS
          pg8::Gemm g{(const bf16*)(ws + WS_P2), (const bf16*)(ws + WS_WPB), DPOOL, DPOOL, DPOOL, 0}; pg8::StaticOrder S; S.init(M, D, G, bid);
          EpiGate<false> E{(const bf16*)a.out, (bf16*)(ws + WS_TMP), (bf16*)(ws + WS_MERGED)};
          pg8::gemm_phase<EpiGate<false>, pg8::StaticOrder, true, true>(lds, g, S, E); }
        { PH_IDS
          pg8::Gemm g{(const bf16*)(ws + WS_OG), (const bf16*)(ws + WS_WRET), D, D, D, 0}; pg8::StaticOrder S; S.init(M, D, G, bid);
          EpiGate<true> E{(const bf16*)a.out, (bf16*)(ws + WS_TMP), (bf16*)(ws + WS_MERGED)};
          pg8::gemm_phase<EpiGate<true>, pg8::StaticOrder, true, true>(lds, g, S, E); }
    }
    xcd_barrier(xbar);

    if constexpr ((PHASES >> 6) & 1) for (int rep_ = 0; rep_ <= ((REPEAT >> 6) & 1); ++rep_) { PH_IDS
        pg8::Gemm g{(const bf16*)(ws + WS_MERGED), (const bf16*)(ws + WS_WOUT), D, D, D, 0}; pg8::StaticOrder S; S.init(M, D, G, bid);
        EpiRes<true> E{a.in[0], (bf16*)(ws + WS_HB), nullptr, (float*)(ws + WS_PART)};
        pg8::gemm_phase<EpiRes<true>, pg8::StaticOrder, true, true>(lds, g, S, E);
    }
    xcd_barrier(xbar);

    if constexpr ((PHASES >> 7) & 1) for (int rep_ = 0; rep_ <= ((REPEAT >> 7) & 1); ++rep_) { PH_IDS
        pg8::Gemm g{(const bf16*)(ws + WS_HB), (const bf16*)(ws + WS_WFI), D, D, D, 0}; pg8::StaticOrder S; S.init(M, 2 * DFF, G, bid);
        EpiSwiglu E{(const float*)(ws + WS_PART), (bf16*)(ws + WS_ACT)};
        pg8::gemm_phase<EpiSwiglu, pg8::StaticOrder, true, true>(lds, g, S, E);
    }
    xcd_barrier(xbar);

    if constexpr ((PHASES >> 8) & 1) for (int rep_ = 0; rep_ <= ((REPEAT >> 8) & 1); ++rep_) { PH_IDS
        pg8::Gemm g{(const bf16*)(ws + WS_ACT), (const bf16*)(ws + WS_WFO), DFF, DFF, DFF, 0}; pg8::StaticOrder S; S.init(M, D, G, bid);
        EpiRes<false> E{nullptr, (bf16*)(ws + WS_HB), a.out, (float*)(ws + WS_PART2)};
        pg8::gemm_phase<EpiRes<false>, pg8::StaticOrder, true, true>(lds, g, S, E);
    }
    xcd_barrier(xbar);

    if constexpr ((PHASES >> 9) & 1) for (int rep_ = 0; rep_ <= ((REPEAT >> 9) & 1); ++rep_) { PH_IDS
        const float* part2 = (const float*)(ws + WS_PART2); const bf16* hb = (const bf16*)(ws + WS_HB); float* out = a.out; const float* gF = a.in[11];
        u32x4 nh[4]; float npv = 0.f;
        if (gw < M) { npv = part2[(size_t)gw * 32 + (lane & 31)];
#pragma unroll
            for (int jj = 0; jj < 4; ++jj) nh[jj] = *(const u32x4*)(hb + (size_t)gw * 2048 + jj * 512 + lane * 8); }
        for (int r = gw; r < M; r += NGW) {
            u32x4 ch[4]; const float cpv = npv;
#pragma unroll
            for (int jj = 0; jj < 4; ++jj) ch[jj] = nh[jj];
            if (r + NGW < M) { npv = part2[(size_t)(r + NGW) * 32 + (lane & 31)];
#pragma unroll
                for (int jj = 0; jj < 4; ++jj) nh[jj] = *(const u32x4*)(hb + (size_t)(r + NGW) * 2048 + jj * 512 + lane * 8); }
            const float tot = wave_sum(cpv) * 0.5f;
            const float rn = 1.0f / sqrtf(tot * (1.0f / 2048.0f) + EPS);
#pragma unroll
            for (int jj = 0; jj < 4; ++jj) { const int c = jj * 512 + lane * 8;
                f32x4 h0, h1; unpack8(ch[jj], h0, h1);
                *(f32x4*)(out + (size_t)r * 2048 + c) = h0 * rn * *(const f32x4*)(gF + c); *(f32x4*)(out + (size_t)r * 2048 + c + 4) = h1 * rn * *(const f32x4*)(gF + c + 4); }
        }
    }
#undef PH_IDS
}

extern "C" void kernel_launch(void* const* d_in, const int* in_sizes, int n_in, void* d_out, int out_size, void* d_ws, size_t ws_size, hipStream_t stream) {
    static int grid = 0;
    if (grid == 0) {
        if (n_in != 12 || in_sizes[0] != M * D || out_size != M * D || ws_size < WS_END) { fprintf(stderr, "kernel_launch: unexpected shapes (n_in %d, in0 %d, out %d, ws %zu < %zu); nothing launched\n", n_in, n_in > 0 ? in_sizes[0] : -1, out_size, ws_size, (size_t)WS_END); grid = -1; return; }
        int dev = 0, cus = 0, per_cu = 0;
        if (hipGetDevice(&dev) != hipSuccess || hipDeviceGetAttribute(&cus, hipDeviceAttributeMultiprocessorCount, dev) != hipSuccess) { grid = -1; return; }
        if (hipFuncSetAttribute((const void*)fwd_megakernel, hipFuncAttributeMaxDynamicSharedMemorySize, LDS_BYTES) != hipSuccess) { fprintf(stderr, "kernel_launch: hipFuncSetAttribute failed\n"); grid = -1; return; }
        if (hipOccupancyMaxActiveBlocksPerMultiprocessor(&per_cu, (const void*)fwd_megakernel, 512, LDS_BYTES) != hipSuccess || per_cu < 1) { fprintf(stderr, "kernel_launch: occupancy query says %d\n", per_cu); per_cu = 1; }
        (void)hipGetLastError();
        grid = cus * per_cu; if (grid > 256) grid = 256;
    }
    if (grid < 0) return;
    if (hipMemsetAsync(d_ws, 0, 16384, stream) != hipSuccess) { fprintf(stderr, "kernel_launch: hipMemsetAsync of the barrier words failed; nothing launched\n"); return; }
    Args a{};
    for (int i = 0; i < 12; ++i) a.in[i] = (const float*)d_in[i];
    a.out = (float*)d_out; a.ws = (unsigned char*)d_ws;
    void* args[] = {&a};
    hipError_t e = hipLaunchCooperativeKernel((const void*)fwd_megakernel, dim3(grid), dim3(512), args, LDS_BYTES, stream);
    if (e != hipSuccess) fprintf(stderr, "kernel_launch: cooperative launch failed: %s (grid %d)\n", hipGetErrorString(e), grid);
}
```
